# Optimizing an MI355X kernel written in HIP

```python
import math
import jax, jax.numpy as jnp
from jax import lax
import numpy as np

D_MODEL = 1024
BATCH = 8
SEQ = 4096
DEPTH = 4
DEC_BATCH = 4
DEC_SEQ = 8192
PAST_LEN = 128

GRID_W = 64
HEAD_DIM = 64
N_HEADS = 8
N_KV = 2
GROUP = N_HEADS // N_KV
ATTN_W = N_HEADS * HEAD_DIM
KV_W = N_KV * HEAD_DIM
CONV_W = D_MODEL // 2
MIX_W = ATTN_W + CONV_W
IN_W = ATTN_W + 2 * KV_W + 3 * CONV_W
SPLITS = (ATTN_W, ATTN_W + KV_W, ATTN_W + 2 * KV_W,
          ATTN_W + 2 * KV_W + CONV_W, ATTN_W + 2 * KV_W + 2 * CONV_W)
D_FF = 2816
CONV_K = 3
Q_BLOCK = 128
ROPE_THETA = 10000.0
AXIS_PAIRS = HEAD_DIM // 4
EPS = 1e-6
ALPHA = (2.0 * DEPTH) ** 0.25
BETA = (8.0 * DEPTH) ** -0.25

kernel_name = "hybrid_parallel_conv_gqa_axial_encoder"


def _layernorm(x, g, b):
    xf = x.astype(jnp.float32)
    mu = jnp.mean(xf, axis=-1, keepdims=True)
    xc = xf - mu
    var = jnp.mean(xc * xc, axis=-1, keepdims=True)
    return (xc * lax.rsqrt(var + EPS) * g.astype(jnp.float32) + b.astype(jnp.float32)).astype(x.dtype)


def _rmsnorm_f32(x, g):
    xf = x.astype(jnp.float32)
    return xf * lax.rsqrt(jnp.mean(xf * xf, axis=-1, keepdims=True) + EPS) * g.astype(jnp.float32)


def _conv3(x, w, b):
    xp = jnp.pad(x, ((0, 0), (1, 1), (0, 0)))
    return xp[:, :-2] * w[0] + xp[:, 1:-1] * w[1] + xp[:, 2:] * w[2] + b


def _axial_rope_tables(seq_len):
    rows = seq_len // GRID_W
    row = jnp.repeat(jnp.arange(rows, dtype=jnp.float32), GRID_W)
    col = jnp.tile(jnp.arange(GRID_W, dtype=jnp.float32), rows)
    inv = ROPE_THETA ** (-jnp.arange(AXIS_PAIRS, dtype=jnp.float32) / AXIS_PAIRS)
    ang = jnp.concatenate([row[:, None] * inv, col[:, None] * inv], axis=-1)
    return jnp.cos(ang), jnp.sin(ang)


def _apply_rope(x, cos, sin):
    xr = x.reshape(x.shape[:-1] + (HEAD_DIM // 2, 2))
    x0, x1 = xr[..., 0], xr[..., 1]
    c = cos[None, :, None, :]
    s = sin[None, :, None, :]
    return jnp.stack([x0 * c - x1 * s, x0 * s + x1 * c], axis=-1).reshape(x.shape)


def _gqa_blocked(q, k, v):
    bsz, seq = q.shape[0], q.shape[1]
    nblk = seq // Q_BLOCK
    qb = q.reshape(bsz, nblk, Q_BLOCK, N_KV, GROUP, HEAD_DIM).transpose(1, 0, 2, 3, 4, 5)
    scale = HEAD_DIM ** -0.5

    def one_block(qi):
        s = jnp.einsum('bqkgd,bskd->bkgqs', qi, k, preferred_element_type=jnp.float32) * scale
        p = jax.nn.softmax(s, axis=-1).astype(v.dtype)
        return jnp.einsum('bkgqs,bskd->bqkgd', p, v)

    o = lax.map(one_block, qb)
    return o.transpose(1, 0, 2, 3, 4, 5).reshape(bsz, seq, ATTN_W)


def _layer(x, cos, sin, w_in, q_norm, k_norm, conv_w, conv_b, w_o, ln1_g, ln1_b,
           w_up, ffn_conv_w, ffn_conv_b, w_down, ln2_g, ln2_b):
    bsz, seq, _ = x.shape
    z = x @ w_in
    q, k, v, c_b, c_c, c_h = jnp.split(z, SPLITS, axis=-1)
    q = _apply_rope(_rmsnorm_f32(q.reshape(bsz, seq, N_HEADS, HEAD_DIM), q_norm), cos, sin)
    q = q.astype(x.dtype).reshape(bsz, seq, N_KV, GROUP, HEAD_DIM)
    k = _apply_rope(_rmsnorm_f32(k.reshape(bsz, seq, N_KV, HEAD_DIM), k_norm), cos, sin).astype(x.dtype)
    v = v.reshape(bsz, seq, N_KV, HEAD_DIM)
    attn_out = _gqa_blocked(q, k, v)
    conv_out = c_b * _conv3(c_c * c_h, conv_w, conv_b)
    mix = jnp.concatenate([attn_out, conv_out], axis=-1) @ w_o
    x = _layernorm(ALPHA * x + mix, ln1_g, ln1_b)
    u = _conv3(x @ w_up, ffn_conv_w, ffn_conv_b)
    gate, val = jnp.split(u, 2, axis=-1)
    ffn = (jax.nn.silu(gate) * val) @ w_down
    return _layernorm(ALPHA * x + ffn, ln2_g, ln2_b)


def _trunk(x, w_in, q_norm, k_norm, conv_w, conv_b, w_o, ln1_g, ln1_b,
           w_up, ffn_conv_w, ffn_conv_b, w_down, ln2_g, ln2_b):
    cos, sin = _axial_rope_tables(x.shape[1])
    for l in range(DEPTH):
        x = _layer(x, cos, sin, w_in[l], q_norm[l], k_norm[l], conv_w[l], conv_b[l], w_o[l],
                   ln1_g[l], ln1_b[l], w_up[l], ffn_conv_w[l], ffn_conv_b[l], w_down[l],
                   ln2_g[l], ln2_b[l])
    return x


def setup_inputs(seed: int = 0) -> dict:
    key = jax.random.key(seed)
    ks = jax.random.split(key, 16)
    f32 = jnp.float32
    nrm = lambda k, shape: jax.random.normal(k, shape, dtype=f32)
    return {
        "x_prompt": nrm(ks[0], (BATCH, SEQ, D_MODEL)),
        "x_sample": nrm(ks[1], (DEC_BATCH, DEC_SEQ, D_MODEL)),
        "w_in": nrm(ks[2], (DEPTH, D_MODEL, IN_W)) * D_MODEL ** -0.5,
        "q_norm": 1.0 + 0.02 * nrm(ks[3], (DEPTH, HEAD_DIM)),
        "k_norm": 1.0 + 0.02 * nrm(ks[4], (DEPTH, HEAD_DIM)),
        "conv_w": nrm(ks[5], (DEPTH, CONV_K, CONV_W)) * CONV_K ** -0.5,
        "conv_b": 0.02 * nrm(ks[6], (DEPTH, CONV_W)),
        "w_o": nrm(ks[7], (DEPTH, MIX_W, D_MODEL)) * (MIX_W ** -0.5 * BETA),
        "ln1_g": 1.0 + 0.02 * nrm(ks[8], (DEPTH, D_MODEL)),
        "ln1_b": 0.02 * nrm(ks[9], (DEPTH, D_MODEL)),
        "w_up": nrm(ks[10], (DEPTH, D_MODEL, 2 * D_FF)) * D_MODEL ** -0.5,
        "ffn_conv_w": nrm(ks[11], (DEPTH, CONV_K, 2 * D_FF)) * CONV_K ** -0.5,
        "ffn_conv_b": 0.02 * nrm(ks[12], (DEPTH, 2 * D_FF)),
        "w_down": nrm(ks[13], (DEPTH, D_FF, D_MODEL)) * (D_FF ** -0.5 * BETA),
        "ln2_g": 1.0 + 0.02 * nrm(ks[14], (DEPTH, D_MODEL)),
        "ln2_b": 0.02 * nrm(ks[15], (DEPTH, D_MODEL)),
    }


def reference(x_prompt, x_sample, w_in, q_norm, k_norm, conv_w, conv_b, w_o, ln1_g, ln1_b,
              w_up, ffn_conv_w, ffn_conv_b, w_down, ln2_g, ln2_b):
    y_prompt = _trunk(x_prompt, w_in, q_norm, k_norm, conv_w, conv_b, w_o, ln1_g, ln1_b,
                      w_up, ffn_conv_w, ffn_conv_b, w_down, ln2_g, ln2_b)
    y_sample = _trunk(x_sample, w_in, q_norm, k_norm, conv_w, conv_b, w_o, ln1_g, ln1_b,
                      w_up, ffn_conv_w, ffn_conv_b, w_down, ln2_g, ln2_b)
    return (y_prompt, y_sample)
```

```cpp
#include <hip/hip_runtime.h>
#include <hip/hip_cooperative_groups.h>
#include <cstdio>
#include <cstdint>
#include <cmath>
namespace cg = cooperative_groups;

namespace pg8 {

#define PG8_LAS __attribute__((address_space(3)))
typedef unsigned short bf16_t;
typedef short bf16x8 __attribute__((ext_vector_type(8)));
typedef float f32x4 __attribute__((ext_vector_type(4)));
typedef unsigned u32x4 __attribute__((ext_vector_type(4)));
constexpr int BM = 256, BK = 64, HALF = 128, HTB = HALF * BK * 2  , STAGE_BYTES = 8 * HTB, NXCD = 8, WGM = 8;

__host__ __device__ __forceinline__ int lds_byte(int r, int c) { const int st = (r >> 4) * 2 + (c >> 5), rr = r & 15, cc = c & 31, ob = rr * 64 + cc * 2; return st * 1024 + (ob ^ (((ob >> 9) & 1) << 5)); }
__host__ __device__ __forceinline__ void stage_rc(int b, int& R, int& C) { const int st = b / 1024, sb = b % 1024, swz = sb ^ (((sb >> 9) & 1) << 5); R = (st >> 1) * 16 + swz / 64; C = (st & 1) * 32 + (swz % 64) / 2; }
__host__ __device__ __forceinline__ int perm32(int rho) { const int n = rho >> 4, i = rho & 15; return 8 * (i >> 2) + 4 * n + (i & 3); }

typedef _Float16 h16x8 __attribute__((ext_vector_type(8)));
template <bool F16> __device__ __forceinline__ f32x4 mma16(bf16x8 a, bf16x8 b, f32x4 c) {
    if constexpr (F16) return __builtin_amdgcn_mfma_f32_16x16x32_f16(__builtin_bit_cast(h16x8, a), __builtin_bit_cast(h16x8, b), c, 0, 0, 0);
    else return __builtin_amdgcn_mfma_f32_16x16x32_bf16(a, b, c, 0, 0, 0);
}
__device__ __forceinline__ unsigned cvt_pk_f16(float lo, float hi) { unsigned r; asm volatile("v_cvt_pk_f16_f32 %0, %1, %2" : "=v"(r) : "v"(lo), "v"(hi)); return r; }
struct Unit { int pm, pn; };
struct Gemm { const bf16_t* A; const bf16_t* Bt; int M, N, K; };

struct StaticOrder {
    int nM, nN, nwg, G, c;
    __host__ __device__ void init(int M, int N, int G_, int c_) { nM = M / BM; nN = N / BM; nwg = nM * nN; G = G_; c = c_; }
    __host__ __device__ bool next(int i, Unit& u) const {
        const long L = (long)i * G + c; if (L >= nwg) return false;
        int wgid = (int)L; { const int q = nwg / NXCD, r = nwg % NXCD, xcd = wgid % NXCD, off = wgid / NXCD; wgid = (xcd < r ? xcd * (q + 1) : r * (q + 1) + (xcd - r) * q) + off; }
        const int nig = WGM * nN, gid = wgid / nig, fm = gid * WGM, gsz = (nM - fm) < WGM ? (nM - fm) : WGM;
        u.pm = fm + ((wgid % nig) % gsz); u.pn = (wgid % nig) / gsz; return true;
    }
    __device__ __forceinline__ void a_ready(const Unit&) const {}
    __device__ __forceinline__ void done(const Unit&) const {}
};

__device__ __forceinline__ unsigned cvt_pk_bf16(float lo, float hi) { unsigned r; asm volatile("v_cvt_pk_bf16_f32 %0, %1, %2" : "=v"(r) : "v"(lo), "v"(hi)); return r; }
typedef float f32x2 __attribute__((ext_vector_type(2)));
template <int ACT  > struct EpiBf16 {
    static constexpr bool PERM = true, AFTER_DRAIN = false; static_assert(ACT == 0, "EpiBf16: ACT is 0");
    bf16_t* O; int ldc; const float* bias; int split_cols; size_t split_stride; float scale0;
    __device__ __forceinline__ void operator()(const f32x4 (&acc)[2][2][4][2], const Unit& u, int wr, int wc, int fr, int fq) const {
        const int row0 = u.pm * BM + wr * 64 + fr; int colt = u.pn * BM; bf16_t* base = O;
        float sc = 1.f; if (split_cols) { const int t = colt / split_cols; base += (size_t)t * split_stride; colt -= t * split_cols; if (t == 0) sc = scale0; }
        const int col0 = colt + wc * 32 + 8 * fq, bcol0 = u.pn * BM + wc * 32 + 8 * fq;
        f32x4 bv[2][2];
#pragma unroll
        for (int bj = 0; bj < 2; ++bj)
#pragma unroll
            for (int n = 0; n < 2; ++n) bv[bj][n] = bias ? *(const f32x4*)(bias + bcol0 + bj * HALF + 4 * n) : (f32x4){0.f, 0.f, 0.f, 0.f};
#pragma unroll
        for (int ai = 0; ai < 2; ++ai)
#pragma unroll
            for (int m = 0; m < 4; ++m) { bf16_t* rowp = base + (size_t)(row0 + ai * HALF + m * 16) * ldc + col0;
#pragma unroll
                for (int bj = 0; bj < 2; ++bj) { f32x4 v0 = acc[ai][bj][m][0] + bv[bj][0], v1 = acc[ai][bj][m][1] + bv[bj][1];
                    v0 = v0 * sc; v1 = v1 * sc; u32x4 w; w.x = cvt_pk_bf16(v0[0], v0[1]); w.y = cvt_pk_bf16(v0[2], v0[3]); w.z = cvt_pk_bf16(v1[0], v1[1]); w.w = cvt_pk_bf16(v1[2], v1[3]);
                    *(u32x4*)(rowp + bj * HALF) = w; } }
    }
};
template <class Epi, class Sched, bool ALIGN_EPI = false, bool SP2 = false, bool F16 = false  >
__device__ __forceinline__ void gemm_phase(PG8_LAS unsigned char* lds, const Gemm g, const Sched& S, const Epi& E) {
    int tid_l = threadIdx.x; asm volatile("" : "+v"(tid_l));
    const int tid = tid_l, wid = __builtin_amdgcn_readfirstlane(tid >> 6), lane = tid & 63, wr = wid >> 2, wc = wid & 3, fr = lane & 15, fq = lane >> 4;
    const int K = g.K, nt = K / BK;
    unsigned voffA[2], voffB[2];
#pragma unroll
    for (int i = 0; i < 2; ++i) { int R, C; stage_rc(tid * 16 + i * 8192, R, C); const int Rb = Epi::PERM ? ((R & ~31) + perm32(R & 31)) : R;
        voffA[i] = (unsigned)(R * K + C) * 2u; voffB[i] = (unsigned)(Rb * K + C) * 2u; }
    const size_t kstep = (size_t)(BK * 2);
    const size_t hstep = (size_t)HALF * K * 2;
    const size_t tstep = 2 * hstep;
    const unsigned ldsw = (unsigned)wid * 1024u;
    const int aoff = lds_byte(wr * 64 + fr, fq * 8), boff = lds_byte(wc * 32 + fr, fq * 8);
#define PG8_SA(b, h) (((b) * 2 + (h)) * HTB)
#define PG8_SB(b, h) ((4 + (b) * 2 + (h)) * HTB)
#define PG8_STAGE(bufoff, gbase, voff) do { _Pragma("unroll") for (int _i = 0; _i < 2; ++_i) \
        __builtin_amdgcn_global_load_lds((const unsigned*)((const char*)(gbase) + (voff)[_i]), (PG8_LAS unsigned*)(lds + (bufoff) + ldsw + _i * 8192), 16, 0, 0); } while (0)
#define PG8_LDA(dst, b, h) do { _Pragma("unroll") for (int m = 0; m < 4; ++m) _Pragma("unroll") for (int k = 0; k < 2; ++k) dst[m][k] = *(const PG8_LAS bf16x8*)(lds + PG8_SA(b, h) + aoff + m * 2048 + k * 1024); } while (0)
#define PG8_LDB(dst, b, h) do { _Pragma("unroll") for (int n = 0; n < 2; ++n) _Pragma("unroll") for (int k = 0; k < 2; ++k) dst[n][k] = *(const PG8_LAS bf16x8*)(lds + PG8_SB(b, h) + boff + n * 2048 + k * 1024); } while (0)
#define PG8_MMA(ai, bj, At, Bt) do { __builtin_amdgcn_s_setprio(1); _Pragma("unroll") for (int m = 0; m < 4; ++m) _Pragma("unroll") for (int n = 0; n < 2; ++n) _Pragma("unroll") for (int k = 0; k < 2; ++k) \
        acc[ai][bj][m][n] = mma16<F16>(Bt[n][k], At[m][k], acc[ai][bj][m][n]); __builtin_amdgcn_s_setprio(0); } while (0)
#define PG8_WAIT_V(n) asm volatile("s_waitcnt vmcnt(" #n ")" ::: "memory")
#define PG8_WAIT_L(n) asm volatile("s_waitcnt lgkmcnt(" #n ")" ::: "memory")
#define PG8_BAR __builtin_amdgcn_s_barrier()
#define PG8_SCHED __builtin_amdgcn_sched_barrier(0)
    Unit cur, nxt; int ui = 0;
    if (!S.next(0, cur)) return;
    f32x4 acc[2][2][4][2];
#pragma unroll
    for (int a = 0; a < 2; ++a)
#pragma unroll
        for (int b = 0; b < 2; ++b)
#pragma unroll
            for (int m = 0; m < 4; ++m)
#pragma unroll
                for (int n = 0; n < 2; ++n) acc[a][b][m][n] = (f32x4){0.f, 0.f, 0.f, 0.f};
    bf16x8 At[4][2], B0[2][2], B1[2][2];
    const char* cA = (const char*)g.A + (size_t)cur.pm * tstep; const char* cB = (const char*)g.Bt + (size_t)cur.pn * tstep;
    S.a_ready(cur);
    if constexpr (SP2) {
        PG8_STAGE(PG8_SB(0, 0), cB, voffB); PG8_STAGE(PG8_SB(0, 1), cB + hstep, voffB); PG8_STAGE(PG8_SA(0, 0), cA, voffA); PG8_STAGE(PG8_SA(0, 1), cA + hstep, voffA);
        if (wr == 1) PG8_BAR;
        PG8_WAIT_V(2); PG8_BAR;
        PG8_STAGE(PG8_SB(1, 0), cB + kstep, voffB); PG8_STAGE(PG8_SA(1, 0), cA + kstep, voffA); PG8_STAGE(PG8_SB(1, 1), cB + hstep + kstep, voffB);
        PG8_WAIT_V(6); PG8_BAR;
    } else {
        PG8_STAGE(PG8_SB(0, 0), cB, voffB); PG8_STAGE(PG8_SA(0, 0), cA, voffA); PG8_STAGE(PG8_SB(0, 1), cB + hstep, voffB); PG8_STAGE(PG8_SA(0, 1), cA + hstep, voffA);
        if (wr == 1) PG8_BAR;
        PG8_WAIT_V(4); PG8_BAR;
        PG8_STAGE(PG8_SB(1, 0), cB + kstep, voffB); PG8_STAGE(PG8_SA(1, 0), cA + kstep, voffA); PG8_STAGE(PG8_SB(1, 1), cB + hstep + kstep, voffB);
        PG8_WAIT_V(6); PG8_BAR;
    }
    for (;;) {
        const bool has_next = S.next(ui + 1, nxt);
        const char* nA = has_next ? (const char*)g.A + (size_t)nxt.pm * tstep : cA; const char* nB = has_next ? (const char*)g.Bt + (size_t)nxt.pn * tstep : cB;
        for (int t = 0; t < nt; t += 2) {
            const bool last = (t == nt - 2);
            const char* a1 = cA + (size_t)(t + 1) * kstep;
            const char* a2 = last ? nA : cA + (size_t)(t + 2) * kstep; const char* b2 = last ? nB : cB + (size_t)(t + 2) * kstep;
            const char* a3 = a2 + kstep; const char* b3 = b2 + kstep;
            if (last && has_next) S.a_ready(nxt);
            if constexpr (SP2) {
            PG8_LDB(B0, 0, 0); PG8_LDB(B1, 0, 1); PG8_SCHED; PG8_LDA(At, 0, 0); PG8_STAGE(PG8_SA(1, 1), a1 + hstep, voffA);
            PG8_WAIT_V(8); PG8_WAIT_L(0); PG8_BAR; PG8_MMA(0, 0, At, B0); PG8_MMA(0, 1, At, B1); PG8_BAR; PG8_SCHED;
            PG8_LDA(At, 0, 1); PG8_STAGE(PG8_SB(0, 0), b2, voffB); PG8_STAGE(PG8_SB(0, 1), b2 + hstep, voffB); PG8_STAGE(PG8_SA(0, 0), a2, voffA);
            PG8_WAIT_V(8); PG8_WAIT_L(0); PG8_BAR; PG8_MMA(1, 0, At, B0); PG8_MMA(1, 1, At, B1); PG8_BAR; PG8_SCHED;
            PG8_LDB(B0, 1, 0); PG8_LDB(B1, 1, 1); PG8_SCHED; PG8_LDA(At, 1, 0); PG8_STAGE(PG8_SA(0, 1), a2 + hstep, voffA);
            PG8_WAIT_V(8); PG8_WAIT_L(0); PG8_BAR; PG8_MMA(0, 0, At, B0); PG8_MMA(0, 1, At, B1); PG8_BAR; PG8_SCHED;
            PG8_LDA(At, 1, 1); PG8_STAGE(PG8_SB(1, 0), b3, voffB); PG8_STAGE(PG8_SB(1, 1), b3 + hstep, voffB); PG8_STAGE(PG8_SA(1, 0), a3, voffA);
            PG8_WAIT_V(8); PG8_WAIT_L(0); PG8_BAR; PG8_MMA(1, 0, At, B0); PG8_MMA(1, 1, At, B1); PG8_BAR; PG8_SCHED;
            } else {
            PG8_LDB(B0, 0, 0); PG8_SCHED; PG8_LDA(At, 0, 0); PG8_STAGE(PG8_SA(1, 1), a1 + hstep, voffA);
            PG8_WAIT_L(8); PG8_BAR; PG8_WAIT_L(0); PG8_MMA(0, 0, At, B0); PG8_BAR; PG8_SCHED;
            PG8_LDB(B1, 0, 1); PG8_STAGE(PG8_SB(0, 0), b2, voffB);
            PG8_BAR; PG8_WAIT_L(0); PG8_MMA(0, 1, At, B1); PG8_BAR;
            PG8_LDA(At, 0, 1); PG8_STAGE(PG8_SA(0, 0), a2, voffA);
            PG8_BAR; PG8_WAIT_L(0); PG8_MMA(1, 0, At, B0); PG8_BAR; PG8_SCHED;
            PG8_STAGE(PG8_SB(0, 1), b2 + hstep, voffB);
            PG8_WAIT_V(6); PG8_BAR; PG8_MMA(1, 1, At, B1); PG8_BAR;
            PG8_LDB(B0, 1, 0); PG8_SCHED; PG8_LDA(At, 1, 0); PG8_STAGE(PG8_SA(0, 1), a2 + hstep, voffA);
            PG8_WAIT_L(8); PG8_BAR; PG8_WAIT_L(0); PG8_MMA(0, 0, At, B0); PG8_BAR; PG8_SCHED;
            PG8_LDB(B1, 1, 1); PG8_STAGE(PG8_SB(1, 0), b3, voffB);
            PG8_BAR; PG8_WAIT_L(0); PG8_MMA(0, 1, At, B1); PG8_BAR;
            PG8_LDA(At, 1, 1); PG8_STAGE(PG8_SA(1, 0), a3, voffA);
            PG8_BAR; PG8_WAIT_L(0); PG8_MMA(1, 0, At, B0); PG8_BAR; PG8_SCHED;
            PG8_STAGE(PG8_SB(1, 1), b3 + hstep, voffB);
            PG8_WAIT_V(6); PG8_BAR; PG8_MMA(1, 1, At, B1); PG8_BAR;
            }
        }
        if constexpr (ALIGN_EPI) { if (wr == 0) PG8_BAR; }
        if constexpr (!Epi::AFTER_DRAIN) { E(acc, cur, wr, wc, fr, fq); S.done(cur); }
        if (!has_next) break;
#pragma unroll
        for (int a = 0; a < 2; ++a)
#pragma unroll
            for (int b = 0; b < 2; ++b)
#pragma unroll
                for (int m = 0; m < 4; ++m)
#pragma unroll
                    for (int n = 0; n < 2; ++n) acc[a][b][m][n] = (f32x4){0.f, 0.f, 0.f, 0.f};
        cur = nxt; cA = nA; cB = nB; ++ui;
        if constexpr (ALIGN_EPI) { if (wr == 1) PG8_BAR; }
    }
    PG8_WAIT_V(0);
    if constexpr (!ALIGN_EPI) { if (wr == 0) PG8_BAR; }
    PG8_BAR;
    if constexpr (Epi::AFTER_DRAIN) { E.fused(acc, cur, wr, wc, fr, fq, lds, wid, lane); S.done(cur); }
#undef PG8_SA
#undef PG8_SB
#undef PG8_STAGE
#undef PG8_LDA
#undef PG8_LDB
#undef PG8_MMA
#undef PG8_WAIT_V
#undef PG8_WAIT_L
#undef PG8_BAR
#undef PG8_SCHED
}
}
#include <hip/hip_bf16.h>
#include <cmath>
namespace attn_body {
using bf16=__hip_bfloat16;
using bf16x8=__attribute__((ext_vector_type(8)))short;
using s16x4=__attribute__((ext_vector_type(4)))short;
using f32x16=__attribute__((ext_vector_type(16)))float;
using u32x4=__attribute__((ext_vector_type(4)))unsigned;
using f32x4_t=__attribute__((ext_vector_type(4)))float;
constexpr int D=64,PQ=2304,PO=1024;
constexpr int NW=8,QBLK=32,QB=QBLK*NW,KVBLK=64;
__device__ __forceinline__ int crow(int r,int hi){return (r&3)+8*(r>>2)+4*hi;}
#define SBAR() __builtin_amdgcn_sched_barrier(0)
__device__ __forceinline__ void cmask(f32x16&p0,f32x16&p1,int jb,int qrel,int hi){
  const float NEG=-INFINITY; int kb=64*jb+4*hi;
  #pragma unroll
  for(int r=0;r<16;++r){int kv=kb+(r&3)+8*(r>>2); if(kv>qrel)p0[r]=NEG; if(kv+32>qrel)p1[r]=NEG;}
}

constexpr int NSLOT=3, SLOTB=8192;
constexpr int LDS_K=0, LDS_V=NSLOT*SLOTB, LDS_WS=2*NSLOT*SLOTB, LDS_OST=LDS_WS+NW*64*4, LDS_BYTES=LDS_OST+NW*4096;
constexpr float C2=0.125f*1.4426950408889634f;
__device__ __forceinline__ void glds16(const void*gsrc,unsigned lds_dst){unsigned keep;
  asm volatile("s_mov_b32 %0, m0\n\ts_mov_b32 m0, %2\n\ts_nop 0\n\tglobal_load_lds_dwordx4 %1, off\n\ts_mov_b32 m0, %0":"=&s"(keep):"v"(gsrc),"s"(lds_dst):"memory");}
__device__ __forceinline__ float max3f(float a,float b,float c){float r;asm("v_max3_f32 %0, %1, %2, %3":"=v"(r):"v"(a),"v"(b),"v"(c));return r;}
__device__ __forceinline__ float max2f(float a,float b){float r;asm("v_max_f32_e32 %0, %1, %2":"=v"(r):"v"(a),"v"(b));return r;}
__device__ __forceinline__ float fadd_s(float a,float b){float r;asm("v_add_f32_e32 %0, %1, %2":"=v"(r):"v"(a),"v"(b));return r;}
__device__ __forceinline__ float fsub_s(float a,float b){float r;asm("v_sub_f32_e32 %0, %1, %2":"=v"(r):"v"(a),"v"(b));return r;}
typedef float f32x2_t __attribute__((ext_vector_type(2))); typedef __bf16 bf16x2_t __attribute__((ext_vector_type(2)));
__device__ __forceinline__ unsigned cvtpk_s(float lo,float hi){f32x2_t v={lo,hi};bf16x2_t b=__builtin_convertvector(v,bf16x2_t);return __builtin_bit_cast(unsigned,b);}
#define WAIT_BAR(N) asm volatile("s_waitcnt vmcnt(" #N ") lgkmcnt(0)\n\ts_barrier":::"memory")

__device__ __forceinline__ void qkt(f32x16&p0,f32x16&p1,const char*Kslot,const bf16x8*qr,const f32x16&negm,int r32,int hi){
  const char*kb=Kslot+hi*1024+r32*16;
  #pragma unroll
  for(int d0=0;d0<4;++d0){
    const bf16x8 b0=*reinterpret_cast<const bf16x8*>(kb+d0*2048);
    const bf16x8 b1=*reinterpret_cast<const bf16x8*>(kb+d0*2048+512);
    if(d0==0){p0=__builtin_amdgcn_mfma_f32_32x32x16_bf16(b0,qr[0],negm,0,0,0);p1=__builtin_amdgcn_mfma_f32_32x32x16_bf16(b1,qr[0],negm,0,0,0);}
    else{p0=__builtin_amdgcn_mfma_f32_32x32x16_bf16(b0,qr[d0],p0,0,0,0);p1=__builtin_amdgcn_mfma_f32_32x32x16_bf16(b1,qr[d0],p1,0,0,0);}}
}
typedef __attribute__((address_space(3))) const char* lds_cptr;
typedef short v4i16_t __attribute__((ext_vector_type(4)));
__device__ __forceinline__ void kload8(bf16x8*kf,lds_cptr kp){
  kf[0]=*(const __attribute__((address_space(3))) bf16x8*)(kp);      kf[1]=*(const __attribute__((address_space(3))) bf16x8*)(kp+512);
  kf[2]=*(const __attribute__((address_space(3))) bf16x8*)(kp+2048); kf[3]=*(const __attribute__((address_space(3))) bf16x8*)(kp+2560);
  kf[4]=*(const __attribute__((address_space(3))) bf16x8*)(kp+4096); kf[5]=*(const __attribute__((address_space(3))) bf16x8*)(kp+4608);
  kf[6]=*(const __attribute__((address_space(3))) bf16x8*)(kp+6144); kf[7]=*(const __attribute__((address_space(3))) bf16x8*)(kp+6656);
}
__device__ __forceinline__ void kload2(bf16x8*kf,lds_cptr kp,int j){ kf[2*j]=*(const __attribute__((address_space(3))) bf16x8*)(kp+j*2048); kf[2*j+1]=*(const __attribute__((address_space(3))) bf16x8*)(kp+j*2048+512); }
__device__ __forceinline__ s16x4 vtr(lds_cptr p){ return __builtin_bit_cast(s16x4,__builtin_amdgcn_ds_read_tr16_b64_v4i16((__attribute__((address_space(3))) v4i16_t*)p)); }
__device__ __forceinline__ float rowmax(const f32x16&p0,const f32x16&p1){
  float a=max3f(p0[0],p0[1],p1[0]),b=max3f(p0[2],p0[3],p1[1]);a=max3f(a,p1[2],p1[3]);
  #pragma unroll
  for(int r=4;r<16;r+=4){a=max3f(a,p0[r],p0[r+1]);b=max3f(b,p0[r+2],p0[r+3]);a=max3f(a,p1[r],p1[r+1]);b=max3f(b,p1[r+2],p1[r+3]);}
  const float m=max2f(a,b);
  auto rr=__builtin_amdgcn_permlane32_swap(__float_as_uint(m),__float_as_uint(m),false,false);
  return max2f(__uint_as_float(rr[0]),__uint_as_float(rr[1]));
}
__device__ __forceinline__ void pv(f32x16*o,int vb,bf16x8 pa0,bf16x8 pa1,bf16x8 pa2,bf16x8 pa3){
  #pragma unroll
  for(int d0=0;d0<2;++d0){s16x4 lo[4],hi[4];
    #pragma unroll
    for(int ks=0;ks<4;++ks){
      asm volatile("ds_read_b64_tr_b16 %0,%1 offset:%c2":"=&v"(lo[ks]):"v"(vb),"i"(d0*4096+ks*1024):"memory");
      asm volatile("ds_read_b64_tr_b16 %0,%1 offset:%c2":"=&v"(hi[ks]):"v"(vb),"i"(d0*4096+ks*1024+512):"memory");}
    asm volatile("s_waitcnt lgkmcnt(0)":::"memory");SBAR();
    #define PK(k) (bf16x8){lo[k][0],lo[k][1],lo[k][2],lo[k][3],hi[k][0],hi[k][1],hi[k][2],hi[k][3]}
    o[d0]=__builtin_amdgcn_mfma_f32_32x32x16_bf16(pa0,PK(0),o[d0],0,0,0);
    o[d0]=__builtin_amdgcn_mfma_f32_32x32x16_bf16(pa1,PK(1),o[d0],0,0,0);
    o[d0]=__builtin_amdgcn_mfma_f32_32x32x16_bf16(pa2,PK(2),o[d0],0,0,0);
    o[d0]=__builtin_amdgcn_mfma_f32_32x32x16_bf16(pa3,PK(3),o[d0],0,0,0);
    #undef PK
  }
}

#ifndef ATTN_STORE16
#define ATTN_STORE16(p,v) (*(u32x4*)(p)=(v))
#endif
template<int THRL> __device__ __forceinline__ void attn_unit(long rowbase,int NT,int q0,const bf16*Qh,const bf16*Kc,const bf16*Vc,bf16*Oh,char*shm,const float*rope,const float*qn){
  int tid_l=threadIdx.x; asm volatile("":"+v"(tid_l)); const int tid=tid_l,lane=tid&63,r32=lane&31,hi=lane>>5; const int wid=__builtin_amdgcn_readfirstlane(tid>>6);
  const bf16*Qw=Qh+(rowbase+q0+wid*QBLK)*PQ;
  const bf16*Kh=Kc+rowbase*PQ,*Vh=Vc+rowbase*PQ;
  const unsigned lds0=(unsigned)(uintptr_t)shm;
  float*wsf=(float*)(shm+LDS_WS)+wid*64;
  const bf16*ksrc=Kh+(long)lane*PQ+wid*8;
  const bf16*vsrc=Vh+(long)(16*(wid&3)+(lane>>2))*PQ+(wid>>2)*32+(lane&3)*8;
  const unsigned kdst=lds0+LDS_K+wid*1024, vdst=lds0+LDS_V+wid*1024;
  #define DMA_K(t,slot) glds16(ksrc+(long)(t)*KVBLK*PQ,(unsigned)__builtin_amdgcn_readfirstlane(kdst+(slot)))
  #define DMA_V(t,slot) glds16(vsrc+(long)(t)*KVBLK*PQ,(unsigned)__builtin_amdgcn_readfirstlane(vdst+(slot)))
  const int vb0=(int)(lds0+LDS_V)+((lane>>4)&1)*32+(lane&3)*8+(4*hi+((lane&15)>>2))*64;
  const char*Kbase=shm+LDS_K; bf16x8 kf[8];
  const lds_cptr shm3=(lds_cptr)shm; const lds_cptr kp0=shm3+LDS_K+hi*1024+r32*16; const lds_cptr vp0=shm3+LDS_V+((lane>>4)&1)*32+(lane&3)*8+(4*hi+((lane&15)>>2))*64;
  DMA_K(0,0);DMA_V(0,0);DMA_K(1,SLOTB);
  bf16x8 qr[4];
  #pragma unroll
  for(int d0=0;d0<4;++d0)qr[d0]=*reinterpret_cast<const bf16x8*>(&Qw[(long)r32*PQ+d0*16+hi*8]);
  { float qf[4][8]; float ss=0.f;
    #pragma unroll
    for(int d0=0;d0<4;++d0){
      #pragma unroll
      for(int i=0;i<8;++i){ qf[d0][i]=__uint_as_float(((unsigned)(unsigned short)qr[d0][i])<<16); ss+=qf[d0][i]*qf[d0][i]; } }
    { auto rr=__builtin_amdgcn_permlane32_swap(__float_as_uint(ss),__float_as_uint(ss),false,false); ss=__uint_as_float(rr[0])+__uint_as_float(rr[1]); }
    const float rn=1.f/sqrtf(ss*(1.f/64.f)+1e-6f);
    const float*rp=rope+((long)(q0+wid*QBLK+r32)*32+hi*4)*2;
    #pragma unroll
    for(int d0=0;d0<4;++d0){
      const f32x4_t c01=*reinterpret_cast<const f32x4_t*>(rp+d0*16), c23=*reinterpret_cast<const f32x4_t*>(rp+d0*16+4);
      const f32x4_t g03=*reinterpret_cast<const f32x4_t*>(qn+d0*16+hi*8), g47=*reinterpret_cast<const f32x4_t*>(qn+d0*16+hi*8+4);
      const float cs_[4]={c01[0],c01[2],c23[0],c23[2]}, sn_[4]={c01[1],c01[3],c23[1],c23[3]}, gg[8]={g03[0],g03[1],g03[2],g03[3],g47[0],g47[1],g47[2],g47[3]};
      unsigned w[4];
      #pragma unroll
      for(int j=0;j<4;++j){ const float y0=qf[d0][2*j]*rn*gg[2*j], y1=qf[d0][2*j+1]*rn*gg[2*j+1];
        w[j]=cvtpk_s((y0*cs_[j]-y1*sn_[j])*C2,(y0*sn_[j]+y1*cs_[j])*C2); }
      qr[d0]=__builtin_bit_cast(bf16x8,(u32x4){w[0],w[1],w[2],w[3]}); } }
  float mhat=0.f,l_reg=0.f;f32x16 o[2];f32x16 negm;
  { float zz=0.f; asm volatile("":"+v"(zz));
    _Pragma("unroll") for(int r=0;r<16;++r){o[0][r]=zz;o[1][r]=zz;negm[r]=zz;} }
  asm volatile("":"+v"(negm));
  #define CMASK(P0,P1,t) do{}while(0)
  bool resc=false;
  #define START(P0,P1) do{ const float rm=rowmax(P0,P1); resc=false; \
    { const float dl=rm; mhat=fadd_s(mhat,dl); \
      _Pragma("unroll") for(int r=0;r<16;++r){P0[r]=fsub_s(P0[r],dl);P1[r]=fsub_s(P1[r],dl);} \
      _Pragma("unroll") for(int r=0;r<16;++r)negm[r]=-mhat; asm volatile("":"+v"(negm)); } \
    _Pragma("unroll") for(int r=0;r<16;++r)P0[r]=__builtin_amdgcn_exp2f(P0[r]); }while(0)
  #define RESC() do{ if(resc){ asm volatile("s_waitcnt lgkmcnt(0)":::"memory"); \
      _Pragma("unroll") for(int d_=0;d_<2;++d_) _Pragma("unroll") for(int r=0;r<16;++r)o[d_][r]*=wsf[crow(r,hi)]; } }while(0)
  f32x16 pA0,pA1,pB0,pB1;
  int sl_prev=0,sl_cur=0,sl_next=SLOTB;
  #define ROT() do{sl_prev=sl_cur;sl_cur=sl_next;sl_next=(sl_next==(NSLOT-1)*SLOTB)?0:sl_next+SLOTB;}while(0)
  DMA_K(2,2*SLOTB);
  WAIT_BAR(3);
  qkt(pA0,pA1,Kbase,qr,negm,r32,hi);asm volatile("s_nop 15\n\ts_nop 7":"+v"(pA0),"+v"(pA1));CMASK(pA0,pA1,0);
  START(pA0,pA1);
  _Pragma("unroll") for(int r=0;r<16;++r)pA1[r]=__builtin_amdgcn_exp2f(pA1[r]);
  WAIT_BAR(0);
  DMA_K(3,0);DMA_V(1,SLOTB);
  ROT();
  kload8(kf,kp0+sl_cur);
  WAIT_BAR(2);
  s16x4 vlo[8],vhi[8]; u32x4 pw0,pw1,pw2,pw3;
  #define PKW(P,B) cvtpk_s(P[B],P[B+1])
  #define PAF(k) __builtin_bit_cast(bf16x8,pw##k)
  #define VFR(i) (bf16x8){vlo[i][0],vlo[i][1],vlo[i][2],vlo[i][3],vhi[i][0],vhi[i][1],vhi[i][2],vhi[i][3]}
  #define PIN(x) asm volatile("":"+v"(x))
  #define MX3(a,b,c) __builtin_fmaxf(__builtin_fmaxf((a),(b)),(c))
  #define GAPA(MF,A0,A1,A2,A3,W0,W1,PW) do{ MF; sacc+=A0; sacc+=A1; sacc+=A2; sacc+=A3; PIN(sacc); W0; W1; PIN(PW); SBAR(); }while(0)
  #define EX(v) __builtin_amdgcn_exp2f(v)
  #define GAPB(MF,X,B) do{ MF; X[B]=EX(X[B]); X[B+1]=EX(X[B+1]); X[B+2]=EX(X[B+2]); X[B+3]=EX(X[B+3]); PIN(X); SBAR(); }while(0)
  #define VRD(i) do{ vlo[i]=vtr(vp_+(((i)>>2)*4096+((i)&3)*1024)); vhi[i]=vtr(vp_+(((i)>>2)*4096+((i)&3)*1024+512)); }while(0)
  #define KRD(G,j) do{ if(G){ kload2(kf,kp0+sl_next,j); SBAR(); } }while(0)
  #define STEP(C0,C1,P0,P1,t,GK,GV,GL) do{ SBAR(); \
    const lds_cptr vp_=vp0+sl_prev; \
    VRD(0); SBAR(); float sacc=(P0[0]+P0[1]); \
    GAPA(C0=__builtin_amdgcn_mfma_f32_32x32x16_bf16(kf[0],qr[0],negm,0,0,0), P0[2],P0[3],P0[4],P0[5],     pw0[0]=PKW(P0,0), pw0[1]=PKW(P0,2), pw0); \
    VRD(4); SBAR(); GAPA(C1=__builtin_amdgcn_mfma_f32_32x32x16_bf16(kf[1],qr[0],negm,0,0,0), P0[6],P0[7],P0[8],P0[9],     pw0[2]=PKW(P0,4), pw0[3]=PKW(P0,6), pw0); \
    VRD(1); SBAR(); GAPA(C0=__builtin_amdgcn_mfma_f32_32x32x16_bf16(kf[2],qr[1],C0,0,0,0),   P0[10],P0[11],P0[12],P0[13], pw1[0]=PKW(P0,8), pw1[1]=PKW(P0,10), pw1); \
    VRD(5); SBAR(); GAPA(C1=__builtin_amdgcn_mfma_f32_32x32x16_bf16(kf[3],qr[1],C1,0,0,0),   P0[14],P0[15],P1[0],P1[1],   pw1[2]=PKW(P0,12),pw1[3]=PKW(P0,14), pw1); \
    VRD(2); SBAR(); GAPA(C0=__builtin_amdgcn_mfma_f32_32x32x16_bf16(kf[4],qr[2],C0,0,0,0),   P1[2],P1[3],P1[4],P1[5],     pw2[0]=PKW(P1,0), pw2[1]=PKW(P1,2), pw2); \
    VRD(6); SBAR(); GAPA(C1=__builtin_amdgcn_mfma_f32_32x32x16_bf16(kf[5],qr[2],C1,0,0,0),   P1[6],P1[7],P1[8],P1[9],     pw2[2]=PKW(P1,4), pw2[3]=PKW(P1,6), pw2); \
    VRD(3); SBAR(); GAPA(C0=__builtin_amdgcn_mfma_f32_32x32x16_bf16(kf[6],qr[3],C0,0,0,0),   P1[10],P1[11],P1[12],P1[13], pw3[0]=PKW(P1,8), pw3[1]=PKW(P1,10), pw3); \
    VRD(7); SBAR(); GAPA(C1=__builtin_amdgcn_mfma_f32_32x32x16_bf16(kf[7],qr[3],C1,0,0,0),   P1[14],P1[15],0.f,0.f,       pw3[2]=PKW(P1,12),pw3[3]=PKW(P1,14), pw3); \
    l_reg+=sacc; \
    if(GK){DMA_K((t)+3,sl_cur);} if(GV){DMA_V((t)+1,sl_next);} \
    CMASK(C0,C1,t); \
    { float a=MX3(C0[0],C0[1],C1[0]),b=MX3(C0[2],C0[3],C1[1]); a=MX3(a,C1[2],C1[3]); \
      _Pragma("unroll") for(int r=4;r<16;r+=4){a=MX3(a,C0[r],C0[r+1]);b=MX3(b,C0[r+2],C0[r+3]);a=MX3(a,C1[r],C1[r+1]);b=MX3(b,C1[r+2],C1[r+3]);} \
      float rm=__builtin_fmaxf(a,b); { auto rr=__builtin_amdgcn_permlane32_swap(__float_as_uint(rm),__float_as_uint(rm),false,false); rm=__builtin_fmaxf(__uint_as_float(rr[0]),__uint_as_float(rr[1])); } \
      resc=false; \
      if(__builtin_expect(__any(rm>(float)THRL),0)){ const float dl=__builtin_fmaxf(rm,0.f); mhat+=dl; \
        _Pragma("unroll") for(int r=0;r<16;++r){C0[r]-=dl;C1[r]-=dl;} \
        _Pragma("unroll") for(int r=0;r<16;++r)negm[r]=-mhat; asm volatile("":"+v"(negm)); \
        const float f=__builtin_amdgcn_exp2f(-dl); l_reg*=f; if(hi==0)wsf[r32]=f; resc=true; } } \
    SBAR(); \
    GAPB(o[0]=__builtin_amdgcn_mfma_f32_32x32x16_bf16(PAF(0),VFR(0),o[0],0,0,0), C0,0); \
    GAPB(o[1]=__builtin_amdgcn_mfma_f32_32x32x16_bf16(PAF(0),VFR(4),o[1],0,0,0), C0,4); \
    KRD(GL,0); GAPB(o[0]=__builtin_amdgcn_mfma_f32_32x32x16_bf16(PAF(1),VFR(1),o[0],0,0,0), C0,8); \
    KRD(GL,1); GAPB(o[1]=__builtin_amdgcn_mfma_f32_32x32x16_bf16(PAF(1),VFR(5),o[1],0,0,0), C0,12); \
    KRD(GL,2); GAPB(o[0]=__builtin_amdgcn_mfma_f32_32x32x16_bf16(PAF(2),VFR(2),o[0],0,0,0), C1,0); \
    KRD(GL,3); GAPB(o[1]=__builtin_amdgcn_mfma_f32_32x32x16_bf16(PAF(2),VFR(6),o[1],0,0,0), C1,4); \
    GAPB(o[0]=__builtin_amdgcn_mfma_f32_32x32x16_bf16(PAF(3),VFR(3),o[0],0,0,0), C1,8); \
    GAPB(o[1]=__builtin_amdgcn_mfma_f32_32x32x16_bf16(PAF(3),VFR(7),o[1],0,0,0), C1,12); \
    }while(0)
  int t=1;
  for(;t+5<NT;t+=2){
    STEP(pB0,pB1,pA0,pA1,t,true,true,true);     WAIT_BAR(2); RESC(); ROT();
    STEP(pA0,pA1,pB0,pB1,t+1,true,true,true);   WAIT_BAR(2); RESC(); ROT();
  }
  #define ENDW(tt) do{ if((tt)+3<NT){WAIT_BAR(2);} else if((tt)+2<NT){WAIT_BAR(1);} else {WAIT_BAR(0);} }while(0)
  for(;t+1<NT;t+=2){
    STEP(pB0,pB1,pA0,pA1,t,(t+3<NT),(t+1<NT),(t+1<NT));       ENDW(t);   RESC(); ROT();
    STEP(pA0,pA1,pB0,pB1,t+1,(t+4<NT),(t+2<NT),(t+2<NT));     ENDW(t+1); RESC(); ROT();
  }
  STEP(pB0,pB1,pA0,pA1,NT-1,false,false,false); RESC();
  { float sacc=pB0[0]+pB0[1]; _Pragma("unroll") for(int r=2;r<16;++r)sacc+=pB0[r]; _Pragma("unroll") for(int r=0;r<16;++r)sacc+=pB1[r]; l_reg+=sacc;
    pw0=(u32x4){PKW(pB0,0),PKW(pB0,2),PKW(pB0,4),PKW(pB0,6)};pw1=(u32x4){PKW(pB0,8),PKW(pB0,10),PKW(pB0,12),PKW(pB0,14)};pw2=(u32x4){PKW(pB1,0),PKW(pB1,2),PKW(pB1,4),PKW(pB1,6)};pw3=(u32x4){PKW(pB1,8),PKW(pB1,10),PKW(pB1,12),PKW(pB1,14)};
    SBAR(); pv(o,vb0+sl_cur,PAF(0),PAF(1),PAF(2),PAF(3)); }
  #undef PKW
  #undef PAF
  #undef VFR
  #undef PIN
  #undef MX3
  #undef GAPA
  #undef GAPB
  #undef EX
  #undef VRD
  #undef KRD
  #undef STEP
  #undef ENDW
  {auto rr=__builtin_amdgcn_permlane32_swap(__float_as_uint(l_reg),__float_as_uint(l_reg),false,false);l_reg=__uint_as_float(rr[0])+__uint_as_float(rr[1]);}
  if(hi==0)wsf[32+r32]=l_reg;asm volatile("s_waitcnt lgkmcnt(0)":::"memory");
  float rli[16];
  #pragma unroll
  for(int r=0;r<16;++r)rli[r]=__builtin_amdgcn_rcpf(wsf[32+crow(r,hi)]);
  bf16*Ow=Oh+(rowbase+q0+wid*QBLK)*PO;
  { bf16*stg=(bf16*)(shm+LDS_OST)+wid*2048;
    #pragma unroll
    for(int r=0;r<16;++r){const int orow=crow(r,hi);
      #pragma unroll
      for(int d0=0;d0<2;++d0)stg[orow*64+d0*32+r32]=__float2bfloat16(o[d0][r]*rli[r]);}
    asm volatile("s_waitcnt lgkmcnt(0)":::"memory");
    #pragma unroll
    for(int i=0;i<4;++i){const int row=i*8+(lane>>3),ch=lane&7; const u32x4 v=*(const u32x4*)(stg+row*64+ch*8); ATTN_STORE16(Ow+(long)row*PO+ch*8,v);} }
  asm volatile("s_waitcnt lgkmcnt(0)\n\ts_barrier":::"memory");
  #undef DMA_K
  #undef DMA_V
  #undef CMASK
  #undef START
  #undef RESC
  #undef ROT
}
constexpr int ATTN_LDS_BYTES=LDS_BYTES;
#undef SBAR
#undef WAIT_BAR
}
namespace mk {
typedef unsigned short bf16_t;
typedef unsigned u32x4 __attribute__((ext_vector_type(4)));
typedef float f32x4 __attribute__((ext_vector_type(4)));
typedef float f2v __attribute__((ext_vector_type(2)));
#define LAS __attribute__((address_space(3)))
constexpr int DM = 1024, MTOK = 65536, MHALF = 32768, INW = 2304, DFF = 2816, UPW = 5632, NLAYER = 4;
constexpr float ALPHA = 1.6817928305074290f, LN_EPS = 1e-6f;
constexpr size_t MiB = 1u << 20;
constexpr size_t WS_ROPE = 1 * MiB, WS_W = 4 * MiB, W_LAYER = 23 * MiB, W_IN = 0, W_O = 4608 * 1024, W_UP = 6656 * 1024, W_DOWN = 17920 * 1024;
constexpr size_t WS_XBF = 96 * MiB, WS_Z = 224 * MiB, WS_MIX = 512 * MiB, WS_H = 224 * MiB  , WS_EDGE = 640 * MiB, WS_SPA = 664 * MiB, WS_SPB = 672 * MiB  ,
                 WS_CDIN = 680 * MiB  , WS_CDUP = 681 * MiB  , WS_PIN = 682 * MiB  , WS_PUP = 684 * MiB  , WS_ONES = 688 * MiB, WS_EDGE2 = 689 * MiB  , WS_BAR = 0  , WS_END = 692 * MiB;
constexpr int BARST_OFF = 131072;
constexpr int ST_OFF = 131072 + 1024 + 8192;
constexpr int HALO_OFF = 131072 + 1024;
constexpr int LDS_BYTES = 147456;

__device__ __forceinline__ float bf2f(unsigned b) { return __uint_as_float(b << 16); }
__device__ __forceinline__ unsigned pk(float lo, float hi) { return pg8::cvt_pk_bf16(lo, hi); }
__device__ __forceinline__ unsigned pkh(float lo, float hi) { return pg8::cvt_pk_f16(lo, hi); }
__device__ __forceinline__ float h2f(unsigned b) { return (float)__builtin_bit_cast(_Float16, (unsigned short)b); }
__device__ __forceinline__ void unpack8h(u32x4 w, float* f) { f[0] = h2f(w.x & 0xffffu); f[1] = h2f(w.x >> 16); f[2] = h2f(w.y & 0xffffu); f[3] = h2f(w.y >> 16);
    f[4] = h2f(w.z & 0xffffu); f[5] = h2f(w.z >> 16); f[6] = h2f(w.w & 0xffffu); f[7] = h2f(w.w >> 16); }
__device__ __forceinline__ void unpack8(u32x4 w, float* f) { f[0] = bf2f(w.x & 0xffffu); f[1] = bf2f(w.x >> 16); f[2] = bf2f(w.y & 0xffffu); f[3] = bf2f(w.y >> 16);
    f[4] = bf2f(w.z & 0xffffu); f[5] = bf2f(w.z >> 16); f[6] = bf2f(w.w & 0xffffu); f[7] = bf2f(w.w >> 16); }
template <int O> __device__ __forceinline__ float swz_xor(float v) { return __int_as_float(__builtin_amdgcn_ds_swizzle(__float_as_int(v), (O << 10) | 0x1f)); }
__device__ __forceinline__ float half_sum(float v) { v += swz_xor<1>(v); v += swz_xor<2>(v); v += swz_xor<4>(v); v += swz_xor<8>(v); v += swz_xor<16>(v); return v; }
__device__ __forceinline__ float wave_sum(float v) { v = half_sum(v); auto rr = __builtin_amdgcn_permlane32_swap(__float_as_uint(v), __float_as_uint(v), false, false); return __uint_as_float(rr[0]) + __uint_as_float(rr[1]); }
__device__ __forceinline__ void transpose_item(const float* W, int K, int N, bf16_t* WT, int pbase, int phalf, const float* gvec, const float* bvec, float2* PART, LAS float* scr, int item, int lane, bool f16 = false) {
    const int nblk = N / 32, kb = item / nblk, nb = item % nblk, k0 = 64 * kb, n0 = 32 * nb;
    int d0 = n0;
    if (phalf && n0 >= pbase) { const int v = (n0 - pbase) >= phalf ? 1 : 0, nn = n0 - pbase - v * phalf; d0 = pbase + 256 * (nn / 128) + 128 * v + (nn % 128); }
#pragma unroll 8
    for (int i = 0; i < 32; ++i) { const int kk = 2 * i + (lane >> 5); scr[kk * 33 + (lane & 31)] = W[(size_t)(k0 + kk) * N + n0 + (lane & 31)]; }
    asm volatile("s_waitcnt lgkmcnt(0)" ::: "memory");
    const int c = lane & 7;
    float gk[8], bk[8];
#pragma unroll
    for (int q = 0; q < 8; ++q) { gk[q] = gvec ? gvec[k0 + 8 * c + q] : 1.f; bk[q] = gvec ? bvec[k0 + 8 * c + q] : 0.f; }
#pragma unroll
    for (int j = 0; j < 4; ++j) { const int n = (lane >> 3) + 8 * j; const LAS float* sp = scr + (8 * c) * 33 + n;
        float w[8]; float ds = 0.f;
#pragma unroll
        for (int q = 0; q < 8; ++q) { const float x = sp[q * 33]; ds += bk[q] * x; w[q] = gk[q] * x; }
        u32x4 o; if (f16) { o.x = pkh(w[0], w[1]); o.y = pkh(w[2], w[3]); o.z = pkh(w[4], w[5]); o.w = pkh(w[6], w[7]); } else { o.x = pk(w[0], w[1]); o.y = pk(w[2], w[3]); o.z = pk(w[4], w[5]); o.w = pk(w[6], w[7]); }
        *(u32x4*)(WT + (size_t)(d0 + n) * K + k0 + 8 * c) = o;
        if (PART) {
            float r8[8]; if (f16) unpack8h(o, r8); else unpack8(o, r8);
            float cs = ((r8[0] + r8[1]) + (r8[2] + r8[3])) + ((r8[4] + r8[5]) + (r8[6] + r8[7]));
            cs += swz_xor<1>(cs); cs += swz_xor<2>(cs); cs += swz_xor<4>(cs); ds += swz_xor<1>(ds); ds += swz_xor<2>(ds); ds += swz_xor<4>(ds);
            if (c == 0) PART[(size_t)kb * N + d0 + n] = make_float2(cs, ds);
        }
    }
    asm volatile("s_waitcnt lgkmcnt(0)" ::: "memory");
}
template <bool NORM, bool WF32 = true, bool WB16 = true> __device__ __forceinline__ void row_pass(const float* src, float* dstf, bf16_t* dstb, const float* g, const float* b, int lane) {
    const f32x4* xr = (const f32x4*)src + lane;
    f32x4 v[4]; float s = 0.f;
#pragma unroll
    for (int j = 0; j < 4; ++j) { v[j] = xr[64 * j]; s += (v[j].x + v[j].y) + (v[j].z + v[j].w); }
    if (NORM) {
        const float mean = wave_sum(s) * (1.f / DM); float s2 = 0.f;
#pragma unroll
        for (int j = 0; j < 4; ++j) { v[j] = v[j] - mean; s2 += (v[j].x * v[j].x + v[j].y * v[j].y) + (v[j].z * v[j].z + v[j].w * v[j].w); }
        const float rstd = 1.f / sqrtf(wave_sum(s2) * (1.f / DM) + LN_EPS);
#pragma unroll
        for (int j = 0; j < 4; ++j) { const f32x4 gg = ((const f32x4*)g)[lane + 64 * j], bb = ((const f32x4*)b)[lane + 64 * j]; v[j] = v[j] * rstd * gg + bb; }
    }
    f32x4* of = (f32x4*)dstf + lane; unsigned long long* ob = (unsigned long long*)dstb + lane;
#pragma unroll
    for (int j = 0; j < 4; ++j) { if (WF32) of[64 * j] = v[j]; if (WB16) ob[64 * j] = (unsigned long long)pkh(v[j].x, v[j].y) | ((unsigned long long)pkh(v[j].z, v[j].w) << 32); }
}
__device__ __forceinline__ void tokpos(int m, int& t, int& S) { if (m < MHALF) { S = 4096; t = m & 4095; } else { S = 8192; t = (m - MHALF) & 8191; } }
__device__ __forceinline__ void prep_row(bf16_t* z, bf16_t* mix, int m, int lane, const float2* rope, const float* qn, const float* kn, const float* cw, const float* cb) {
    int t, S; tokpos(m, t, S);
    bf16_t* zr = z + (size_t)m * INW;
    const int p = lane & 31, hh = lane >> 5;
    const float2 cs = rope[t * 32 + p];
    const float gq0 = qn[2 * p], gq1 = qn[2 * p + 1], gk0 = kn[2 * p], gk1 = kn[2 * p + 1];
    {
        const int head = 8 + hh; unsigned* wp = (unsigned*)(zr + head * 64 + 2 * p); const unsigned w = *wp;
        const float x0 = bf2f(w & 0xffffu), x1 = bf2f(w >> 16);
        float ss = x0 * x0 + x1 * x1;
        ss = half_sum(ss);
        const float r = 1.f / sqrtf(ss * (1.f / 64.f) + LN_EPS);
        const bool isq = head < 8;
        const float y0 = x0 * r * (isq ? gq0 : gk0), y1 = x1 * r * (isq ? gq1 : gk1);
        float o0 = y0 * cs.x - y1 * cs.y, o1 = y0 * cs.y + y1 * cs.x;
        if (isq) { o0 *= attn_body::C2; o1 *= attn_body::C2; }
        *wp = pk(o0, o1);
    }
}
__device__ __forceinline__ void conv_mix_unit(const bf16_t* Z, bf16_t* mix, const float* E2, const float* cw, const float* cbias, long row0, int h, int t0, int S, int tid) {
    const int pm = (int)(row0 >> 8);
#pragma unroll
    for (int it = 0; it < 4; ++it) {
        const int idx = tid + 512 * it, r = idx >> 3, ch = h * 64 + (idx & 7) * 8; const size_t row = (size_t)row0 + r;
        float fb[8], cp[8];
        unpack8(*(const u32x4*)(Z + row * INW + 768 + ch), fb);
        if (r == 0 || r == 255) {
            const float* Ep = E2 + (size_t)pm * 4 * 512 + ch; const bool last = r == 255;
            const float* r0 = last ? Ep + 2 * 512 : Ep - 512; const float* r1 = last ? Ep + 3 * 512 : Ep; const float* r2 = last ? Ep + 4 * 512 : Ep + 512;
            const bool hasp = t0 + r > 0, hasn = t0 + r < S - 1;
#pragma unroll
            for (int i = 0; i < 8; ++i) cp[i] = cw[ch + i] * (hasp ? r0[i] : 0.f) + cw[512 + ch + i] * r1[i] + cw[1024 + ch + i] * (hasn ? r2[i] : 0.f) + cbias[ch + i];
        } else unpack8(*(const u32x4*)(Z + row * INW + 1280 + ch), cp);
        u32x4 w; w.x = pk(fb[0] * cp[0], fb[1] * cp[1]); w.y = pk(fb[2] * cp[2], fb[3] * cp[3]); w.z = pk(fb[4] * cp[4], fb[5] * cp[5]); w.w = pk(fb[6] * cp[6], fb[7] * cp[7]);
        *(u32x4*)(mix + row * DM + 512 + ch) = w;
    }
}
__device__ __forceinline__ void row_stats_to_lds(const float* SP, int pm, LAS f2v* T, int tid) {
    if (tid < 256) { const f32x4* p = (const f32x4*)(SP + (size_t)(pm * 256 + tid) * 32); float s1 = 0.f, s2 = 0.f;
#pragma unroll
        for (int k = 0; k < 8; ++k) { const f32x4 v = p[k]; s1 += v.x + v.z; s2 += v.y + v.w; }
        const float mu = s1 * (1.f / DM), var = s2 * (1.f / DM) - mu * mu;
        T[tid] = (f2v){mu, 1.f / sqrtf(var + LN_EPS)}; }
    asm volatile("s_waitcnt lgkmcnt(0)" ::: "memory"); __builtin_amdgcn_s_barrier(); asm volatile("" ::: "memory");
}
#define DPPF(old, src, ctrl) __int_as_float(__builtin_amdgcn_update_dpp(__float_as_int(old), __float_as_int(src), (ctrl), 0xf, 0xf, false))
#define DPPZ(src, ctrl) __int_as_float(__builtin_amdgcn_update_dpp(0, __float_as_int(src), (ctrl), 0xf, 0xf, true))
__device__ __forceinline__ float silu_mul(float G, float V) { return G * __builtin_amdgcn_rcpf(1.f + __builtin_amdgcn_exp2f(-1.4426950408889634f * G)) * V; }
struct EpiFfn {
    static constexpr bool PERM = true, AFTER_DRAIN = false;
    bf16_t* H; float* E; const float* fw; const float* fb; LAS float* R; const float* SP; const float* cvec; const float* dvec; LAS f2v* T;
    __device__ __forceinline__ void operator()(pg8::f32x4 (&acc)[2][2][4][2], const pg8::Unit& u, int wr, int wc, int fr, int fq) const {
        typedef pg8::f32x4 f4;
        const int cidx = (wc * 4 + fq) * 16, cl = 32 * wc + 8 * fq;
        row_stats_to_lds(SP, u.pm, T, (wr * 4 + wc) * 64 + fq * 16 + fr);
#pragma unroll
        for (int bj = 0; bj < 2; ++bj)
#pragma unroll
            for (int n = 0; n < 2; ++n) { const f4 cv = *(const f4*)(cvec + u.pn * 256 + 128 * bj + cl + 4 * n), dv = *(const f4*)(dvec + u.pn * 256 + 128 * bj + cl + 4 * n);
#pragma unroll
                for (int ai = 0; ai < 2; ++ai)
#pragma unroll
                    for (int m = 0; m < 4; ++m) { const f2v st = T[ai * 128 + wr * 64 + m * 16 + fr]; acc[ai][bj][m][n] = acc[ai][bj][m][n] * st.y + (cv * (-st.x * st.y) + dv); } }
#pragma unroll
        for (int ai = 0; ai < 2; ++ai) { const int s = 2 * ai + wr;
            if (fr == 0) {
#pragma unroll
                for (int bj = 0; bj < 2; ++bj)
#pragma unroll
                    for (int n = 0; n < 2; ++n) *(LAS f4*)(R + (2 * s) * 256 + cidx + (bj * 2 + n) * 4) = acc[ai][bj][0][n]; }
            if (fr == 15) {
#pragma unroll
                for (int bj = 0; bj < 2; ++bj)
#pragma unroll
                    for (int n = 0; n < 2; ++n) *(LAS f4*)(R + (2 * s + 1) * 256 + cidx + (bj * 2 + n) * 4) = acc[ai][bj][3][n]; } }
        { float* Eb = E + (size_t)u.pm * 4 * UPW + u.pn * 256 + cl;
            if (wr == 0 && fr < 2) {
#pragma unroll
                for (int bj = 0; bj < 2; ++bj)
#pragma unroll
                    for (int n = 0; n < 2; ++n) *(f4*)(Eb + fr * UPW + 128 * bj + 4 * n) = acc[0][bj][0][n]; }
            if (wr == 1 && fr >= 14) {
#pragma unroll
                for (int bj = 0; bj < 2; ++bj)
#pragma unroll
                    for (int n = 0; n < 2; ++n) *(f4*)(Eb + (fr - 12) * UPW + 128 * bj + 4 * n) = acc[1][bj][3][n]; } }
        asm volatile("s_waitcnt lgkmcnt(0)" ::: "memory"); __builtin_amdgcn_s_barrier(); asm volatile("" ::: "memory");
#pragma unroll
        for (int n = 0; n < 2; ++n) {
            const int chg = 128 * u.pn + cl + 4 * n;
            const f4 w0g = *(const f4*)(fw + chg), w1g = *(const f4*)(fw + UPW + chg), w2g = *(const f4*)(fw + 2 * UPW + chg), bg = *(const f4*)(fb + chg);
            const f4 w0v = *(const f4*)(fw + DFF + chg), w1v = *(const f4*)(fw + UPW + DFF + chg), w2v = *(const f4*)(fw + 2 * UPW + DFF + chg), bv = *(const f4*)(fb + DFF + chg);
#pragma unroll
            for (int ai = 0; ai < 2; ++ai) { const int s = 2 * ai + wr;
                const int ra = (s > 0 ? 2 * s - 1 : 0) * 256 + cidx + n * 4, rb = (s < 3 ? 2 * s + 2 : 7) * 256 + cidx + n * 4;
                const f4 abg = *(const LAS f4*)(R + ra), abv = *(const LAS f4*)(R + ra + 8), beg = *(const LAS f4*)(R + rb), bev = *(const LAS f4*)(R + rb + 8);
#pragma unroll
                for (int e = 0; e < 4; ++e) {
                    float opg = 0.f, opv = 0.f;
#pragma unroll
                    for (int m = 0; m < 4; ++m) {
                        const float cg_ = acc[ai][0][m][n][e], cv_ = acc[ai][1][m][n][e];
                        float tg, tv, ng, nv;
                        if (m == 0) { tg = abg[e]; tv = abv[e]; } else { tg = DPPZ(opg, 0x10F); tv = DPPZ(opv, 0x10F); }
                        if (m == 3) { ng = beg[e]; nv = bev[e]; } else { ng = DPPZ(acc[ai][0][m + 1][n][e], 0x11F); nv = DPPZ(acc[ai][1][m + 1][n][e], 0x11F); }
                        const float pg_ = DPPF(tg, cg_, 0x111), pv_ = DPPF(tv, cv_, 0x111);
                        const float xg_ = DPPF(ng, cg_, 0x101), xv_ = DPPF(nv, cv_, 0x101);
                        const float Gv = w0g[e] * pg_ + w1g[e] * cg_ + w2g[e] * xg_ + bg[e];
                        const float Vv = w0v[e] * pv_ + w1v[e] * cv_ + w2v[e] * xv_ + bv[e];
                        opg = cg_; opv = cv_;
                        acc[ai][0][m][n][e] = silu_mul(Gv, Vv);
                    }
                    __builtin_amdgcn_sched_barrier(0);
                }
            }
        }
#pragma unroll
        for (int ai = 0; ai < 2; ++ai)
#pragma unroll
            for (int m = 0; m < 4; ++m) { bf16_t* p = H + (size_t)(u.pm * pg8::BM + ai * pg8::HALF + wr * 64 + m * 16 + fr) * DFF + 128 * u.pn + cl;
                const f4 v0 = acc[ai][0][m][0], v1 = acc[ai][0][m][1];
                u32x4 w; w.x = pk(v0[0], v0[1]); w.y = pk(v0[2], v0[3]); w.z = pk(v1[0], v1[1]); w.w = pk(v1[2], v1[3]);
                *(u32x4*)p = w; }
    }
};
__device__ __forceinline__ void ffn_fix_item(const float* E, bf16_t* H, int pm, int which, int ch, const float* fw, const float* fb) {
    const int m = pm * 256 + (which ? 255 : 0); int t, S; tokpos(m, t, S);
    const int j = ch >> 4, i8 = (ch & 15) * 8, ucg = 256 * j + i8, cg_ = 128 * j + i8, cv_ = DFF + cg_;
    const float* Ep = E + (size_t)pm * 4 * UPW + ucg;
    const float* r0 = which ? Ep + 2 * UPW : Ep - UPW;
    const float* r1 = which ? Ep + 3 * UPW : Ep;
    const float* r2 = which ? Ep + 4 * UPW : Ep + UPW;
    const bool hasp = t > 0, hasn = t < S - 1;
    float o[8];
#pragma unroll
    for (int i = 0; i < 8; ++i) {
        const float gm = hasp ? r0[i] : 0.f, vm = hasp ? r0[128 + i] : 0.f, gp = hasn ? r2[i] : 0.f, vp = hasn ? r2[128 + i] : 0.f;
        const float G = fw[cg_ + i] * gm + fw[UPW + cg_ + i] * r1[i] + fw[2 * UPW + cg_ + i] * gp + fb[cg_ + i];
        const float V = fw[cv_ + i] * vm + fw[UPW + cv_ + i] * r1[128 + i] + fw[2 * UPW + cv_ + i] * vp + fb[cv_ + i];
        o[i] = silu_mul(G, V);
    }
    u32x4 w; w.x = pk(o[0], o[1]); w.y = pk(o[2], o[3]); w.z = pk(o[4], o[5]); w.w = pk(o[6], o[7]);
    *(u32x4*)(H + (size_t)m * DFF + cg_) = w;
}
struct EpiZ {
    static constexpr bool PERM = true, AFTER_DRAIN = false;
    bf16_t* O; const float* SP; const float* cvec; const float* dvec; LAS f2v* T; float* E2; const float* cw; const float* cbias; LAS float* R; const float* rope; const float* kn;
    __device__ __forceinline__ void store_tile(const pg8::f32x4 (&acc)[2][2][4][2], const pg8::Unit& u, int wr, int wc, int fr, int fq) const {
        typedef pg8::f32x4 f4;
        asm volatile("" : "+v"(fr));
        const int cbs = u.pn * 256 + wc * 32 + 8 * fq;
#pragma unroll
        for (int ai = 0; ai < 2; ++ai)
#pragma unroll
            for (int m = 0; m < 4; ++m) { bf16_t* rowp = O + (size_t)(u.pm * 256 + ai * 128 + wr * 64 + m * 16 + fr) * INW + cbs;
#pragma unroll
                for (int bj = 0; bj < 2; ++bj) { const f4 v0 = acc[ai][bj][m][0], v1 = acc[ai][bj][m][1];
                    u32x4 w; w.x = pk(v0[0], v0[1]); w.y = pk(v0[2], v0[3]); w.z = pk(v1[0], v1[1]); w.w = pk(v1[2], v1[3]);
                    *(u32x4*)(rowp + bj * 128) = w; } }
    }
    __device__ __forceinline__ void conv_tile(pg8::f32x4 (&acc)[2][2][4][2], const pg8::Unit& u, int wr, int wc, int fr, int fq) const {
        typedef pg8::f32x4 f4;
        const int cidx = (wc * 4 + fq) * 8, cl = 32 * wc + 8 * fq, jt = u.pn - 5;
#pragma unroll
        for (int ai = 0; ai < 2; ++ai)
#pragma unroll
            for (int m = 0; m < 4; ++m)
#pragma unroll
                for (int n = 0; n < 2; ++n) acc[ai][0][m][n] = acc[ai][0][m][n] * acc[ai][1][m][n];
#pragma unroll
        for (int ai = 0; ai < 2; ++ai) { const int s = 2 * ai + wr;
            if (fr == 0) {
#pragma unroll
                for (int n = 0; n < 2; ++n) *(LAS f4*)(R + (2 * s) * 128 + cidx + n * 4) = acc[ai][0][0][n]; }
            if (fr == 15) {
#pragma unroll
                for (int n = 0; n < 2; ++n) *(LAS f4*)(R + (2 * s + 1) * 128 + cidx + n * 4) = acc[ai][0][3][n]; } }
        { float* Eb = E2 + (size_t)u.pm * 4 * 512 + jt * 128 + cl;
            if (wr == 0 && fr < 2) {
#pragma unroll
                for (int n = 0; n < 2; ++n) *(f4*)(Eb + fr * 512 + 4 * n) = acc[0][0][0][n]; }
            if (wr == 1 && fr >= 14) {
#pragma unroll
                for (int n = 0; n < 2; ++n) *(f4*)(Eb + (fr - 12) * 512 + 4 * n) = acc[1][0][3][n]; } }
        asm volatile("s_waitcnt lgkmcnt(0)" ::: "memory"); __builtin_amdgcn_s_barrier(); asm volatile("" ::: "memory");
#pragma unroll
        for (int n = 0; n < 2; ++n) {
            const int ch = 128 * jt + cl + 4 * n;
            const f4 w0 = *(const f4*)(cw + ch), w1 = *(const f4*)(cw + 512 + ch), w2 = *(const f4*)(cw + 1024 + ch), bb = *(const f4*)(cbias + ch);
#pragma unroll
            for (int ai = 0; ai < 2; ++ai) { const int s = 2 * ai + wr;
                const int ra = (s > 0 ? 2 * s - 1 : 0) * 128 + cidx + n * 4, rb = (s < 3 ? 2 * s + 2 : 7) * 128 + cidx + n * 4;
                const f4 ab = *(const LAS f4*)(R + ra), be = *(const LAS f4*)(R + rb);
#pragma unroll
                for (int e = 0; e < 4; ++e) {
#pragma unroll
                    for (int m = 0; m < 4; ++m) {
                        const float c_ = acc[ai][0][m][n][e];
                        const float tp = (m == 0) ? ab[e] : DPPZ(acc[ai][0][m - 1][n][e], 0x10F);
                        const float tn = (m == 3) ? be[e] : DPPZ(acc[ai][0][m + 1][n][e], 0x11F);
                        const float pv_ = DPPF(tp, c_, 0x111), nx_ = DPPF(tn, c_, 0x101);
                        acc[ai][1][m][n][e] = w0[e] * pv_ + w1[e] * c_ + w2[e] * nx_ + bb[e];
                    }
                    __builtin_amdgcn_sched_barrier(0);
                }
            }
        }
#pragma unroll
        for (int ai = 0; ai < 2; ++ai)
#pragma unroll
            for (int m = 0; m < 4; ++m) { bf16_t* p = O + (size_t)(u.pm * 256 + ai * 128 + wr * 64 + m * 16 + fr) * INW + 1280 + 128 * jt + cl;
                const f4 v0 = acc[ai][1][m][0], v1 = acc[ai][1][m][1];
                u32x4 w; w.x = pk(v0[0], v0[1]); w.y = pk(v0[2], v0[3]); w.z = pk(v1[0], v1[1]); w.w = pk(v1[2], v1[3]);
                *(u32x4*)p = w; }
    }
    __device__ __forceinline__ void operator()(pg8::f32x4 (&acc)[2][2][4][2], const pg8::Unit& u, int wr, int wc, int fr, int fq) const {
        typedef pg8::f32x4 f4;
        row_stats_to_lds(SP, u.pm, T, (wr * 4 + wc) * 64 + fq * 16 + fr);
        const int cb = u.pn * 256 + wc * 32 + 8 * fq;
        f4 cv[2][2], dv[2][2];
#pragma unroll
        for (int bj = 0; bj < 2; ++bj)
#pragma unroll
            for (int n = 0; n < 2; ++n) { cv[bj][n] = *(const f4*)(cvec + cb + 128 * bj + 4 * n); dv[bj][n] = *(const f4*)(dvec + cb + 128 * bj + 4 * n); }
#pragma unroll
        for (int ai = 0; ai < 2; ++ai)
#pragma unroll
            for (int m = 0; m < 4; ++m) { const int rl = ai * 128 + wr * 64 + m * 16 + fr; const f2v st = T[rl]; const float r = st.y, rm = -st.x * st.y;
#pragma unroll
                for (int bj = 0; bj < 2; ++bj) { acc[ai][bj][m][0] = acc[ai][bj][m][0] * r + (cv[bj][0] * rm + dv[bj][0]); acc[ai][bj][m][1] = acc[ai][bj][m][1] * r + (cv[bj][1] * rm + dv[bj][1]); } }
        if (u.pn >= 5) { conv_tile(acc, u, wr, wc, fr, fq); return; }
        if (u.pn == 2) {
            float part[2][4];
            asm volatile("" : "+v"(fr), "+v"(fq));
#pragma unroll
            for (int ai = 0; ai < 2; ++ai)
#pragma unroll
                for (int m = 0; m < 4; ++m) { const f4 a0 = acc[ai][0][m][0], a1 = acc[ai][0][m][1];
                    float ss = ((a0[0] * a0[0] + a0[1] * a0[1]) + (a0[2] * a0[2] + a0[3] * a0[3])) + ((a1[0] * a1[0] + a1[1] * a1[1]) + (a1[2] * a1[2] + a1[3] * a1[3]));
                    ss += swz_xor<16>(ss); { auto rr = __builtin_amdgcn_permlane32_swap(__float_as_uint(ss), __float_as_uint(ss), false, false); ss = __uint_as_float(rr[0]) + __uint_as_float(rr[1]); }
                    part[ai][m] = ss; if (fq == 0) R[(ai * 128 + wr * 64 + m * 16 + fr) * 4 + wc] = ss; }
            asm volatile("s_waitcnt lgkmcnt(0)" ::: "memory"); __builtin_amdgcn_s_barrier(); asm volatile("" ::: "memory");
            const int dim0 = (wc & 1) * 32 + 8 * fq;
            const f4 g0 = *(const f4*)(kn + dim0), g1 = *(const f4*)(kn + dim0 + 4);
#pragma unroll
            for (int ai = 0; ai < 2; ++ai)
#pragma unroll
                for (int m = 0; m < 4; ++m) { const int rl = ai * 128 + wr * 64 + m * 16 + fr;
                    const float tot = part[ai][m] + R[rl * 4 + (wc ^ 1)], rn = 1.f / sqrtf(tot * (1.f / 64.f) + LN_EPS);
                    int t, S; tokpos(u.pm * 256 + rl, t, S);
                    const float* rp = rope + ((size_t)t * 32 + (dim0 >> 1)) * 2;
                    const f4 c01 = *(const f4*)rp, c23 = *(const f4*)(rp + 4);
                    const f4 a0 = acc[ai][0][m][0] * rn * g0, a1 = acc[ai][0][m][1] * rn * g1;
                    acc[ai][0][m][0] = (f4){a0[0] * c01[0] - a0[1] * c01[1], a0[0] * c01[1] + a0[1] * c01[0], a0[2] * c01[2] - a0[3] * c01[3], a0[2] * c01[3] + a0[3] * c01[2]};
                    acc[ai][0][m][1] = (f4){a1[0] * c23[0] - a1[1] * c23[1], a1[0] * c23[1] + a1[1] * c23[0], a1[2] * c23[2] - a1[3] * c23[3], a1[2] * c23[3] + a1[3] * c23[2]};
                    asm volatile("" ::: "memory"); __builtin_amdgcn_sched_barrier(0); }
            store_tile(acc, u, wr, wc, fr, fq); return;
        }
        store_tile(acc, u, wr, wc, fr, fq);
    }
};
struct EpiResLn {
    static constexpr bool PERM = true, AFTER_DRAIN = false;
    float* X; bf16_t* XB; const float* SPin; float* SPout; const float* g; const float* b; LAS f2v* T; float alpha;
    __device__ __forceinline__ void operator()(pg8::f32x4 (&acc)[2][2][4][2], const pg8::Unit& u, int wr, int wc, int fr, int fq) const {
        typedef pg8::f32x4 f4;
        row_stats_to_lds(SPin, u.pm, T, (wr * 4 + wc) * 64 + fq * 16 + fr);
        const int cb = u.pn * 256 + wc * 32 + 8 * fq;
        f4 gv[2][2], bv[2][2];
#pragma unroll
        for (int bj = 0; bj < 2; ++bj)
#pragma unroll
            for (int n = 0; n < 2; ++n) { gv[bj][n] = *(const f4*)(g + cb + 128 * bj + 4 * n); bv[bj][n] = *(const f4*)(b + cb + 128 * bj + 4 * n); }
#pragma unroll
        for (int ai = 0; ai < 2; ++ai)
#pragma unroll
            for (int m = 0; m < 4; ++m) { const int rl = ai * 128 + wr * 64 + m * 16 + fr; const f2v st = T[rl]; const float r = st.y, rm = -st.x * st.y;
                const size_t off = (size_t)(u.pm * 256 + rl) * DM + cb; float s1 = 0.f, s2 = 0.f;
#pragma unroll
                for (int bj = 0; bj < 2; ++bj) { f4 pre[2]; float xin[8]; unpack8h(*(const u32x4*)(XB + off + 128 * bj), xin);
#pragma unroll
                    for (int n = 0; n < 2; ++n) { const f4 v = {xin[4 * n], xin[4 * n + 1], xin[4 * n + 2], xin[4 * n + 3]}; const f4 xr = (v * r + rm) * gv[bj][n] + bv[bj][n];
                        pre[n] = xr * alpha + acc[ai][bj][m][n]; if (X) *(f4*)(X + off + 128 * bj + 4 * n) = pre[n];
                        s1 += (pre[n][0] + pre[n][1]) + (pre[n][2] + pre[n][3]); s2 += (pre[n][0] * pre[n][0] + pre[n][1] * pre[n][1]) + (pre[n][2] * pre[n][2] + pre[n][3] * pre[n][3]); }
                    u32x4 w; w.x = pkh(pre[0][0], pre[0][1]); w.y = pkh(pre[0][2], pre[0][3]); w.z = pkh(pre[1][0], pre[1][1]); w.w = pkh(pre[1][2], pre[1][3]);
                    if (!X) *(u32x4*)(XB + off + 128 * bj) = w; }
                s1 += swz_xor<16>(s1); s2 += swz_xor<16>(s2);
                { auto r1 = __builtin_amdgcn_permlane32_swap(__float_as_uint(s1), __float_as_uint(s1), false, false); s1 = __uint_as_float(r1[0]) + __uint_as_float(r1[1]);
                  auto r2 = __builtin_amdgcn_permlane32_swap(__float_as_uint(s2), __float_as_uint(s2), false, false); s2 = __uint_as_float(r2[0]) + __uint_as_float(r2[1]); }
                if (fq == 0) *(f2v*)(SPout + (size_t)(u.pm * 256 + rl) * 32 + (u.pn * 4 + wc) * 2) = (f2v){s1, s2};
            }
    }
};

#define XB_TMO      128
#define XB_XCNT(j)  (256  + 64 * (j))
#define XB_XSUB(j)  (1280 + 64 * (j))
#define XB_XGEN(j)  (2304 + 64 * (j))
#define XB_TOP      3328
#define XB_TOPGEN   3392
#define XCD_BAR_WORDS 3456
#define XB_SPIN_CAP (1u << 18)

__device__ __forceinline__ unsigned xb_ld(unsigned* p)              { return __hip_atomic_load(p, __ATOMIC_RELAXED, __HIP_MEMORY_SCOPE_AGENT); }
__device__ __forceinline__ unsigned xb_add(unsigned* p, unsigned v) { return __hip_atomic_fetch_add(p, v, __ATOMIC_RELAXED, __HIP_MEMORY_SCOPE_AGENT); }
__device__ __forceinline__ unsigned xb_xcc_id() { return (unsigned)__builtin_amdgcn_s_getreg((3 << 11) | 20) & 0xFu; }
#define XB_SPIN(cond, bar) do { unsigned _sp = 0; while (cond) { __builtin_amdgcn_s_sleep(1); \
    if ((++_sp & 255u) == 0u) { if (xb_ld(&(bar)[XB_TMO])) break; if (_sp > XB_SPIN_CAP) { atomicAdd(&(bar)[XB_TMO], 1u); break; } } } } while (0)

struct XcdBarrier {
    unsigned* bar; unsigned x;
    volatile LAS unsigned* st;
};

__device__ __forceinline__ XcdBarrier xcd_barrier_post(unsigned* bar, volatile LAS unsigned* st) {
    XcdBarrier b; b.bar = bar; b.x = xb_xcc_id(); b.st = st;
    if (threadIdx.x == 0) (void)xb_add(&bar[XB_XCNT(b.x)], 1u);
    return b;
}
__device__ __forceinline__ void xcd_barrier_complete(unsigned* bar, unsigned x, unsigned& nloc, unsigned& nx) {
    const unsigned G = gridDim.x * gridDim.y * gridDim.z;
    unsigned sum, cnt, mine, sp = 0u;
    for (;;) {
        sum = 0u; cnt = 0u; mine = 0u;
#pragma unroll
        for (unsigned j = 0; j < 16; ++j) { const unsigned c = xb_ld(&bar[XB_XCNT(j)]); sum += c; cnt += (c > 0u) ? 1u : 0u; mine = (j == x) ? c : mine; }
        if (sum == G) break;
        __builtin_amdgcn_s_sleep(1);
        if ((++sp & 255u) == 0u) { if (xb_ld(&bar[XB_TMO])) break; if (sp > XB_SPIN_CAP) { atomicAdd(&bar[XB_TMO], 1u); break; } }
    }
    nloc = mine > 0u ? mine : 1u; nx = cnt > 0u ? cnt : 1u;
}

__device__ __forceinline__ void xcd_barrier(const XcdBarrier& b) {
    asm volatile("s_waitcnt vmcnt(0)" ::: "memory");
    __syncthreads();
    if (threadIdx.x == 0) {
        unsigned* bar = b.bar;
        __builtin_amdgcn_s_waitcnt(0);
        unsigned nloc = b.st[0], nx = b.st[1];
        if (nloc == 0u) { xcd_barrier_complete(bar, b.x, nloc, nx); b.st[0] = nloc; b.st[1] = nx; }
        const unsigned old = xb_add(&bar[XB_XSUB(b.x)], 1u);
        const unsigned gen = old / nloc;
        if (old + 1u == (gen + 1u) * nloc) {
            __builtin_amdgcn_fence(__ATOMIC_RELEASE, "agent");
            asm volatile("s_waitcnt vmcnt(0)" ::: "memory");
            const unsigned og = xb_add(&bar[XB_TOP], 1u);
            const unsigned tg = og / nx;
            if (og + 1u == (tg + 1u) * nx) xb_add(&bar[XB_TOPGEN], 1u);
            else XB_SPIN(xb_ld(&bar[XB_TOPGEN]) == tg, bar);
            __builtin_amdgcn_fence(__ATOMIC_ACQUIRE, "agent");
            xb_add(&bar[XB_XGEN(b.x)], 1u);
            asm volatile("s_waitcnt vmcnt(0)" ::: "memory");
        } else {
            XB_SPIN(xb_ld(&bar[XB_XGEN(b.x)]) == gen, bar);
            __builtin_amdgcn_fence(__ATOMIC_ACQUIRE, "agent");
            asm volatile("s_waitcnt vmcnt(0)" ::: "memory");
        }
    }
    __syncthreads();
}

struct Args { const float* in[16]; float* out; unsigned char* ws; };

#define ENV() \
    const __attribute__((address_space(4))) Args* ap = kp; asm volatile("" : "+s"(ap)); \
    int tid = threadIdx.x; asm volatile("" : "+v"(tid)); \
    const int lane = tid & 63, wave = __builtin_amdgcn_readfirstlane(tid >> 6); \
    const int G = gridDim.x, bx = blockIdx.x; \
    const int vcu = (G % 8 == 0) ? (bx % 8) * (G / 8) + bx / 8 : bx; \
    const int gw = vcu * 8 + wave, NGW = G * 8; \
    const size_t gtid = (size_t)bx * 512 + tid, gsz = (size_t)G * 512; \
    unsigned char* ws = ap->ws; float* X = ap->out; \
    bf16_t* XBF = (bf16_t*)(ws + WS_XBF); bf16_t* Z = (bf16_t*)(ws + WS_Z); bf16_t* MIX = (bf16_t*)(ws + WS_MIX); \
    bf16_t* H = (bf16_t*)(ws + WS_H); float* EDGE = (float*)(ws + WS_EDGE); float2* ROPE = (float2*)(ws + WS_ROPE); \
    float* SPA = (float*)(ws + WS_SPA); float* SPB = (float*)(ws + WS_SPB); float* CDIN = (float*)(ws + WS_CDIN); float* CDUP = (float*)(ws + WS_CDUP); \
    float2* PIN = (float2*)(ws + WS_PIN); float2* PUP = (float2*)(ws + WS_PUP); float* ONES = (float*)(ws + WS_ONES); float* EDGE2 = (float*)(ws + WS_EDGE2); (void)EDGE2; LAS f2v* TST = (LAS f2v*)((LAS unsigned char*)lds + ST_OFF); \
    (void)SPA; (void)SPB; (void)CDIN; (void)CDUP; (void)PIN; (void)PUP; (void)ONES; (void)TST; \
    (void)lane; (void)wave; (void)gw; (void)NGW; (void)gtid; (void)gsz; (void)X; (void)XBF; (void)Z; (void)MIX; (void)EDGE; (void)H; (void)ROPE;

__global__ void __launch_bounds__(512, 2) mega_fwd(Args a_unused) {
    extern __shared__ __attribute__((aligned(16))) unsigned char lds[];
    cg::grid_group grid = cg::this_grid();
    const __attribute__((address_space(4))) Args* kp = (const __attribute__((address_space(4))) Args*)__builtin_amdgcn_kernarg_segment_ptr();

    if (threadIdx.x < 2) ((volatile LAS unsigned*)((LAS unsigned char*)lds + BARST_OFF))[threadIdx.x] = 0u;
    __syncthreads();
    {
        ENV();
        if (bx == 0) for (int i = tid; i < XCD_BAR_WORDS; i += 512) ((unsigned*)(ws + WS_BAR))[i] = 0u;
        LAS float* scr = (LAS float*)((LAS unsigned char*)lds + wave * 16384);
        constexpr int I_IN = 16 * 72, I_O = 16 * 32, I_UP = 16 * 176, I_DN = 44 * 32, I_L = I_IN + I_O + I_UP + I_DN;
        for (int it = gw; it < NLAYER * I_L; it += NGW) {
            const int l = it / I_L; int r = it % I_L; unsigned char* wl = ws + WS_W + (size_t)l * W_LAYER;
            if (r < I_IN) { const bool f = l > 0;
                transpose_item(ap->in[2] + (size_t)l * DM * INW, DM, INW, (bf16_t*)(wl + W_IN), 1280, 512, f ? ap->in[14] + (l - 1) * DM : nullptr, f ? ap->in[15] + (l - 1) * DM : nullptr,
                               f ? PIN + (size_t)l * 16 * INW : nullptr, scr, r, lane, true); continue; } r -= I_IN;
            if (r < I_O) { transpose_item(ap->in[7] + (size_t)l * DM * DM, DM, DM, (bf16_t*)(wl + W_O), 0, 0, nullptr, nullptr, nullptr, scr, r, lane); continue; } r -= I_O;
            if (r < I_UP) { transpose_item(ap->in[10] + (size_t)l * DM * UPW, DM, UPW, (bf16_t*)(wl + W_UP), 0, DFF, ap->in[8] + l * DM, ap->in[9] + l * DM, PUP + (size_t)l * 16 * UPW, scr, r, lane, true); continue; } r -= I_UP;
            transpose_item(ap->in[13] + (size_t)l * DFF * DM, DFF, DM, (bf16_t*)(wl + W_DOWN), 0, 0, nullptr, nullptr, nullptr, scr, r, lane);
        }
        for (size_t i = gtid; i < (size_t)MTOK * 8; i += gsz) ((f32x4*)SPB)[i] = (i & 7) == 0 ? (f32x4){0.f, (float)DM * (1.f - LN_EPS), 0.f, 0.f} : (f32x4){0.f, 0.f, 0.f, 0.f};
        for (size_t i = gtid; i < 2048; i += gsz) ONES[i] = i < 1024 ? 1.f : 0.f;
        for (size_t i = gtid; i < 2 * INW; i += gsz) CDIN[i] = 0.f;
        for (size_t i = gtid; i < 8192 * 32; i += gsz) {
            const int t = (int)(i >> 5), p = (int)(i & 31); const int pos = p < 16 ? (t >> 6) : (t & 63);
            const float angf = (float)pos * __builtin_amdgcn_exp2f(-(float)(p & 15) * 0.83048202372184059f);
            double r = (double)angf; r -= 6.283185307179586476925 * __builtin_rint(r * 0.15915494309189533577);
            const double r2 = r * r; double sn, cs;
            sn = -1.0 / 51090942171709440000.0; cs = 1.0 / 2432902008176640000.0;
            sn = sn * r2 + 1.0 / 121645100408832000.0; cs = cs * r2 - 1.0 / 6402373705728000.0;
            sn = sn * r2 - 1.0 / 355687428096000.0;    cs = cs * r2 + 1.0 / 20922789888000.0;
            sn = sn * r2 + 1.0 / 1307674368000.0;      cs = cs * r2 - 1.0 / 87178291200.0;
            sn = sn * r2 - 1.0 / 6227020800.0;         cs = cs * r2 + 1.0 / 479001600.0;
            sn = sn * r2 + 1.0 / 39916800.0;           cs = cs * r2 - 1.0 / 3628800.0;
            sn = sn * r2 - 1.0 / 362880.0;             cs = cs * r2 + 1.0 / 40320.0;
            sn = sn * r2 + 1.0 / 5040.0;               cs = cs * r2 - 1.0 / 720.0;
            sn = sn * r2 - 1.0 / 120.0;                cs = cs * r2 + 1.0 / 24.0;
            sn = sn * r2 + 1.0 / 6.0;                  cs = cs * r2 - 1.0 / 2.0;
            sn = sn * r2 - 1.0; sn = -sn * r;          cs = cs * r2 + 1.0;
            ROPE[i] = make_float2((float)cs, (float)sn);
        }
        for (int m = gw; m < MTOK; m += NGW) {
            const float* src = m < MHALF ? ap->in[0] + (size_t)m * DM : ap->in[1] + (size_t)(m - MHALF) * DM;
            row_pass<false, false>(src, nullptr, XBF + (size_t)m * DM, nullptr, nullptr, lane);
        }
    }
    grid.sync();
    const XcdBarrier xbar = xcd_barrier_post((unsigned*)(kp->ws + WS_BAR), (volatile LAS unsigned*)((LAS unsigned char*)lds + BARST_OFF));

#pragma nounroll
    for (int l = 0; l < NLAYER; ++l) {
        {
            ENV(); unsigned char* wl = ws + WS_W + (size_t)l * W_LAYER;
            pg8::Gemm g{XBF, (const bf16_t*)(wl + W_IN), MTOK, INW, DM}; pg8::StaticOrder S; S.init(MTOK, INW, G, bx);
            EpiZ E{Z, SPB, CDIN + (size_t)l * 2 * INW, CDIN + (size_t)l * 2 * INW + INW, TST, EDGE2, ap->in[5] + l * 3 * 512, ap->in[6] + l * 512, (LAS float*)((LAS unsigned char*)lds + HALO_OFF), (const float*)ROPE, ap->in[4] + l * 64};
            pg8::gemm_phase<EpiZ, pg8::StaticOrder, true, true, true>((LAS unsigned char*)lds, g, S, E);
        }
        xcd_barrier(xbar);
        {
            ENV();
            if (l == 0) {
                for (size_t i = gtid; i < (size_t)3 * INW + 4 * UPW; i += gsz) {
                    const bool up = i >= (size_t)3 * INW; const int N = up ? UPW : INW; const int r = up ? (int)(i - 3 * INW) : (int)i + INW, ll = r / N, n = r % N;
                    const float2* P = (up ? PUP : PIN) + (size_t)ll * 16 * N + n; float cs = 0.f, ds = 0.f;
#pragma unroll
                    for (int kb = 0; kb < 16; ++kb) { const float2 v = P[(size_t)kb * N]; cs += v.x; ds += v.y; }
                    float* CD = (up ? CDUP : CDIN) + (size_t)ll * 2 * N; CD[n] = cs; CD[N + n] = ds;
                }
            }
            const int xcd = vcu >> 5, jc = vcu & 31;
#pragma nounroll
            for (int i = 0; i < 8; ++i) {
                long rowbase; int NT, qb, h, kvh;
                if (i < 4) { const int ui = jc * 4 + i; kvh = xcd & 1; h = kvh * 4 + (ui >> 5); qb = ui & 31; rowbase = MHALF + (long)(xcd >> 1) * 8192; NT = 128; }
                else { const int ui = jc * 4 + (i - 4), pair = 2 * xcd + (ui >> 6), r = ui & 63; kvh = pair & 1; h = kvh * 4 + (r >> 4); qb = r & 15; rowbase = (long)(pair >> 1) * 4096; NT = 64; }
                attn_body::attn_unit<8>(rowbase, NT, qb * 256, (const attn_body::bf16*)(Z + h * 64), (const attn_body::bf16*)(Z + 512 + kvh * 64), (const attn_body::bf16*)(Z + 640 + kvh * 64),
                                        (attn_body::bf16*)(MIX + h * 64), (char*)lds, (const float*)ROPE, ap->in[3] + l * 64);
                conv_mix_unit(Z, MIX, EDGE2, ap->in[5] + l * 3 * 512, ap->in[6] + l * 512, rowbase + qb * 256, h, qb * 256, NT * 64, tid);
            }
        }
        xcd_barrier(xbar);
        {
            ENV(); unsigned char* wl = ws + WS_W + (size_t)l * W_LAYER;
            pg8::Gemm g{MIX, (const bf16_t*)(wl + W_O), MTOK, DM, DM}; pg8::StaticOrder S; S.init(MTOK, DM, G, bx);
            EpiResLn E{nullptr, XBF, SPB, SPA, l > 0 ? ap->in[14] + (l - 1) * DM : ONES, l > 0 ? ap->in[15] + (l - 1) * DM : ONES + 1024, TST, ALPHA};
            pg8::gemm_phase<EpiResLn, pg8::StaticOrder, true, true>((LAS unsigned char*)lds, g, S, E);
        }
        xcd_barrier(xbar);
        {
            ENV(); unsigned char* wl = ws + WS_W + (size_t)l * W_LAYER;
            pg8::Gemm g{XBF, (const bf16_t*)(wl + W_UP), MTOK, UPW, DM}; pg8::StaticOrder S; S.init(MTOK, UPW, G, bx);
            EpiFfn E{H, EDGE, ap->in[11] + (size_t)l * 3 * UPW, ap->in[12] + (size_t)l * UPW, (LAS float*)((LAS unsigned char*)lds + HALO_OFF), SPA, CDUP + (size_t)l * 2 * UPW, CDUP + (size_t)l * 2 * UPW + UPW, TST};
            pg8::gemm_phase<EpiFfn, pg8::StaticOrder, true, true, true>((LAS unsigned char*)lds, g, S, E);
        }
        xcd_barrier(xbar);
        {
            ENV();
            const float* fw = ap->in[11] + (size_t)l * 3 * UPW; const float* fb = ap->in[12] + (size_t)l * UPW;
            for (size_t it = gtid; it < (size_t)512 * 352; it += gsz) { const int rr = (int)(it / 352), ch = (int)(it % 352); ffn_fix_item(EDGE, H, rr >> 1, rr & 1, ch, fw, fb); }
        }
        xcd_barrier(xbar);
        {
            ENV(); unsigned char* wl = ws + WS_W + (size_t)l * W_LAYER;
            pg8::Gemm g{H, (const bf16_t*)(wl + W_DOWN), MTOK, DM, DFF}; pg8::StaticOrder S; S.init(MTOK, DM, G, bx);
            EpiResLn E{l == NLAYER - 1 ? X : nullptr, XBF, SPA, SPB, ap->in[8] + l * DM, ap->in[9] + l * DM, TST, ALPHA};
            pg8::gemm_phase<EpiResLn, pg8::StaticOrder, true, true>((LAS unsigned char*)lds, g, S, E);
        }
        xcd_barrier(xbar);
    }
    {
        ENV();
        for (int m = gw; m < MTOK; m += NGW) row_pass<true, true, false>(X + (size_t)m * DM, X + (size_t)m * DM, nullptr, ap->in[14] + (NLAYER - 1) * DM, ap->in[15] + (NLAYER - 1) * DM, lane);
    }
}
}

extern "C" void kernel_launch(void* const* d_in, const int* in_sizes, int n_in, void* d_out, int out_size, void* d_ws, size_t ws_size, hipStream_t stream) {
    static int grid = 0;
    if (grid == 0) {
        if (n_in != 16 || out_size != mk::MTOK * mk::DM || ws_size < mk::WS_END) { fprintf(stderr, "kernel_launch: unexpected shapes (n_in %d out %d ws %zu)\n", n_in, out_size, ws_size); grid = -1; return; }
        int dev = 0, cus = 0, per_cu = 0;
        (void)hipGetDevice(&dev);
        (void)hipDeviceGetAttribute(&cus, hipDeviceAttributeMultiprocessorCount, dev);
        (void)hipFuncSetAttribute((const void*)mk::mega_fwd, hipFuncAttributeMaxDynamicSharedMemorySize, mk::LDS_BYTES);
        (void)hipOccupancyMaxActiveBlocksPerMultiprocessor(&per_cu, (const void*)mk::mega_fwd, 512, mk::LDS_BYTES);
        (void)hipGetLastError();
        grid = cus;
        fprintf(stderr, "kernel_launch: cus %d per_cu %d grid %d\n", cus, per_cu, grid);
    }
    if (grid < 0) return;
    mk::Args a{};
    for (int i = 0; i < 16; ++i) a.in[i] = (const float*)d_in[i];
    a.out = (float*)d_out; a.ws = (unsigned char*)d_ws;
    void* args[] = {&a};
    hipError_t e = hipLaunchCooperativeKernel((const void*)mk::mega_fwd, dim3(grid), dim3(512), args, mk::LDS_BYTES, stream);
    if (e != hipSuccess) fprintf(stderr, "cooperative launch failed: %s (grid %d)\n", hipGetErrorString(e), grid);
}
```

```cpp
#include <hip/hip_runtime.h>
#include <hip/hip_cooperative_groups.h>
#include <cstdio>
#include <cstdint>
#include <cmath>
namespace cg = cooperative_groups;

namespace pg8 {

#define PG8_LAS __attribute__((address_space(3)))
typedef unsigned short bf16_t;
typedef short bf16x8 __attribute__((ext_vector_type(8)));
typedef float f32x4 __attribute__((ext_vector_type(4)));
typedef unsigned u32x4 __attribute__((ext_vector_type(4)));
constexpr int BM = 256, BK = 64, HALF = 128, HTB = HALF * BK * 2  , STAGE_BYTES = 8 * HTB, NXCD = 8, WGM = 8;

__host__ __device__ __forceinline__ int lds_byte(int r, int c) { const int st = (r >> 4) * 2 + (c >> 5), rr = r & 15, cc = c & 31, ob = rr * 64 + cc * 2; return st * 1024 + (ob ^ (((ob >> 9) & 1) << 5)); }
__host__ __device__ __forceinline__ void stage_rc(int b, int& R, int& C) { const int st = b / 1024, sb = b % 1024, swz = sb ^ (((sb >> 9) & 1) << 5); R = (st >> 1) * 16 + swz / 64; C = (st & 1) * 32 + (swz % 64) / 2; }
__host__ __device__ __forceinline__ int perm32(int rho) { const int n = rho >> 4, i = rho & 15; return 8 * (i >> 2) + 4 * n + (i & 3); }

typedef _Float16 h16x8 __attribute__((ext_vector_type(8)));
template <bool F16> __device__ __forceinline__ f32x4 mma16(bf16x8 a, bf16x8 b, f32x4 c) {
    if constexpr (F16) return __builtin_amdgcn_mfma_f32_16x16x32_f16(__builtin_bit_cast(h16x8, a), __builtin_bit_cast(h16x8, b), c, 0, 0, 0);
    else return __builtin_amdgcn_mfma_f32_16x16x32_bf16(a, b, c, 0, 0, 0);
}
__device__ __forceinline__ unsigned cvt_pk_f16(float lo, float hi) { unsigned r; asm volatile("v_cvt_pk_f16_f32 %0, %1, %2" : "=v"(r) : "v"(lo), "v"(hi)); return r; }
struct Unit { int pm, pn; };
struct Gemm { const bf16_t* A; const bf16_t* Bt; int M, N, K; };

struct StaticOrder {
    int nM, nN, nwg, G, c;
    __host__ __device__ void init(int M, int N, int G_, int c_) { nM = M / BM; nN = N / BM; nwg = nM * nN; G = G_; c = c_; }
    __host__ __device__ bool next(int i, Unit& u) const {
        const long L = (long)i * G + c; if (L >= nwg) return false;
        int wgid = (int)L; { const int q = nwg / NXCD, r = nwg % NXCD, xcd = wgid % NXCD, off = wgid / NXCD; wgid = (xcd < r ? xcd * (q + 1) : r * (q + 1) + (xcd - r) * q) + off; }
        const int nig = WGM * nN, gid = wgid / nig, fm = gid * WGM, gsz = (nM - fm) < WGM ? (nM - fm) : WGM;
        u.pm = fm + ((wgid % nig) % gsz); u.pn = (wgid % nig) / gsz; return true;
    }
    __device__ __forceinline__ void a_ready(const Unit&) const {}
    __device__ __forceinline__ void done(const Unit&) const {}
};

__device__ __forceinline__ unsigned cvt_pk_bf16(float lo, float hi) { unsigned r; asm volatile("v_cvt_pk_bf16_f32 %0, %1, %2" : "=v"(r) : "v"(lo), "v"(hi)); return r; }
typedef float f32x2 __attribute__((ext_vector_type(2)));
template <int ACT  > struct EpiBf16 {
    static constexpr bool PERM = true, AFTER_DRAIN = false; static_assert(ACT == 0, "EpiBf16: ACT is 0");
    bf16_t* O; int ldc; const float* bias; int split_cols; size_t split_stride; float scale0;
    __device__ __forceinline__ void operator()(const f32x4 (&acc)[2][2][4][2], const Unit& u, int wr, int wc, int fr, int fq) const {
        const int row0 = u.pm * BM + wr * 64 + fr; int colt = u.pn * BM; bf16_t* base = O;
        float sc = 1.f; if (split_cols) { const int t = colt / split_cols; base += (size_t)t * split_stride; colt -= t * split_cols; if (t == 0) sc = scale0; }
        const int col0 = colt + wc * 32 + 8 * fq, bcol0 = u.pn * BM + wc * 32 + 8 * fq;
        f32x4 bv[2][2];
#pragma unroll
        for (int bj = 0; bj < 2; ++bj)
#pragma unroll
            for (int n = 0; n < 2; ++n) bv[bj][n] = bias ? *(const f32x4*)(bias + bcol0 + bj * HALF + 4 * n) : (f32x4){0.f, 0.f, 0.f, 0.f};
#pragma unroll
        for (int ai = 0; ai < 2; ++ai)
#pragma unroll
            for (int m = 0; m < 4; ++m) { bf16_t* rowp = base + (size_t)(row0 + ai * HALF + m * 16) * ldc + col0;
#pragma unroll
                for (int bj = 0; bj < 2; ++bj) { f32x4 v0 = acc[ai][bj][m][0] + bv[bj][0], v1 = acc[ai][bj][m][1] + bv[bj][1];
                    v0 = v0 * sc; v1 = v1 * sc; u32x4 w; w.x = cvt_pk_bf16(v0[0], v0[1]); w.y = cvt_pk_bf16(v0[2], v0[3]); w.z = cvt_pk_bf16(v1[0], v1[1]); w.w = cvt_pk_bf16(v1[2], v1[3]);
                    *(u32x4*)(rowp + bj * HALF) = w; } }
    }
};
template <class Epi, class Sched, bool ALIGN_EPI = false, bool SP2 = false, bool F16 = false  >
__device__ __forceinline__ void gemm_phase(PG8_LAS unsigned char* lds, const Gemm g, const Sched& S, const Epi& E) {
    int tid_l = threadIdx.x; asm volatile("" : "+v"(tid_l));
    const int tid = tid_l, wid = __builtin_amdgcn_readfirstlane(tid >> 6), lane = tid & 63, wr = wid >> 2, wc = wid & 3, fr = lane & 15, fq = lane >> 4;
    const int K = g.K, nt = K / BK;
    unsigned voffA[2], voffB[2];
#pragma unroll
    for (int i = 0; i < 2; ++i) { int R, C; stage_rc(tid * 16 + i * 8192, R, C); const int Rb = Epi::PERM ? ((R & ~31) + perm32(R & 31)) : R;
        voffA[i] = (unsigned)(R * K + C) * 2u; voffB[i] = (unsigned)(Rb * K + C) * 2u; }
    const size_t kstep = (size_t)(BK * 2);
    const size_t hstep = (size_t)HALF * K * 2;
    const size_t tstep = 2 * hstep;
    const unsigned ldsw = (unsigned)wid * 1024u;
    const int aoff = lds_byte(wr * 64 + fr, fq * 8), boff = lds_byte(wc * 32 + fr, fq * 8);
#define PG8_SA(b, h) (((b) * 2 + (h)) * HTB)
#define PG8_SB(b, h) ((4 + (b) * 2 + (h)) * HTB)
#define PG8_STAGE(bufoff, gbase, voff) do { _Pragma("unroll") for (int _i = 0; _i < 2; ++_i) \
        __builtin_amdgcn_global_load_lds((const unsigned*)((const char*)(gbase) + (voff)[_i]), (PG8_LAS unsigned*)(lds + (bufoff) + ldsw + _i * 8192), 16, 0, 0); } while (0)
#define PG8_LDA(dst, b, h) do { _Pragma("unroll") for (int m = 0; m < 4; ++m) _Pragma("unroll") for (int k = 0; k < 2; ++k) dst[m][k] = *(const PG8_LAS bf16x8*)(lds + PG8_SA(b, h) + aoff + m * 2048 + k * 1024); } while (0)
#define PG8_LDB(dst, b, h) do { _Pragma("unroll") for (int n = 0; n < 2; ++n) _Pragma("unroll") for (int k = 0; k < 2; ++k) dst[n][k] = *(const PG8_LAS bf16x8*)(lds + PG8_SB(b, h) + boff + n * 2048 + k * 1024); } while (0)
#define PG8_MMA(ai, bj, At, Bt) do { __builtin_amdgcn_s_setprio(1); _Pragma("unroll") for (int m = 0; m < 4; ++m) _Pragma("unroll") for (int n = 0; n < 2; ++n) _Pragma("unroll") for (int k = 0; k < 2; ++k) \
        acc[ai][bj][m][n] = mma16<F16>(Bt[n][k], At[m][k], acc[ai][bj][m][n]); __builtin_amdgcn_s_setprio(0); } while (0)
#define PG8_WAIT_V(n) asm volatile("s_waitcnt vmcnt(" #n ")" ::: "memory")
#define PG8_WAIT_L(n) asm volatile("s_waitcnt lgkmcnt(" #n ")" ::: "memory")
#define PG8_BAR __builtin_amdgcn_s_barrier()
#define PG8_SCHED __builtin_amdgcn_sched_barrier(0)
    Unit cur, nxt; int ui = 0;
    if (!S.next(0, cur)) return;
    f32x4 acc[2][2][4][2];
#pragma unroll
    for (int a = 0; a < 2; ++a)
#pragma unroll
        for (int b = 0; b < 2; ++b)
#pragma unroll
            for (int m = 0; m < 4; ++m)
#pragma unroll
                for (int n = 0; n < 2; ++n) acc[a][b][m][n] = (f32x4){0.f, 0.f, 0.f, 0.f};
    bf16x8 At[4][2], B0[2][2], B1[2][2];
    const char* cA = (const char*)g.A + (size_t)cur.pm * tstep; const char* cB = (const char*)g.Bt + (size_t)cur.pn * tstep;
    S.a_ready(cur);
    if constexpr (SP2) {
        PG8_STAGE(PG8_SB(0, 0), cB, voffB); PG8_STAGE(PG8_SB(0, 1), cB + hstep, voffB); PG8_STAGE(PG8_SA(0, 0), cA, voffA); PG8_STAGE(PG8_SA(0, 1), cA + hstep, voffA);
        if (wr == 1) PG8_BAR;
        PG8_WAIT_V(2); PG8_BAR;
        PG8_STAGE(PG8_SB(1, 0), cB + kstep, voffB); PG8_STAGE(PG8_SA(1, 0), cA + kstep, voffA); PG8_STAGE(PG8_SB(1, 1), cB + hstep + kstep, voffB);
        PG8_WAIT_V(6); PG8_BAR;
    } else {
        PG8_STAGE(PG8_SB(0, 0), cB, voffB); PG8_STAGE(PG8_SA(0, 0), cA, voffA); PG8_STAGE(PG8_SB(0, 1), cB + hstep, voffB); PG8_STAGE(PG8_SA(0, 1), cA + hstep, voffA);
        if (wr == 1) PG8_BAR;
        PG8_WAIT_V(4); PG8_BAR;
        PG8_STAGE(PG8_SB(1, 0), cB + kstep, voffB); PG8_STAGE(PG8_SA(1, 0), cA + kstep, voffA); PG8_STAGE(PG8_SB(1, 1), cB + hstep + kstep, voffB);
        PG8_WAIT_V(6); PG8_BAR;
    }
    for (;;) {
        const bool has_next = S.next(ui + 1, nxt);
        const char* nA = has_next ? (const char*)g.A + (size_t)nxt.pm * tstep : cA; const char* nB = has_next ? (const char*)g.Bt + (size_t)nxt.pn * tstep : cB;
        for (int t = 0; t < nt; t += 2) {
            const bool last = (t == nt - 2);
            const char* a1 = cA + (size_t)(t + 1) * kstep;
            const char* a2 = last ? nA : cA + (size_t)(t + 2) * kstep; const char* b2 = last ? nB : cB + (size_t)(t + 2) * kstep;
            const char* a3 = a2 + kstep; const char* b3 = b2 + kstep;
            if (last && has_next) S.a_ready(nxt);
            if constexpr (SP2) {
            PG8_LDB(B0, 0, 0); PG8_LDB(B1, 0, 1); PG8_SCHED; PG8_LDA(At, 0, 0); PG8_STAGE(PG8_SA(1, 1), a1 + hstep, voffA);
            PG8_WAIT_V(8); PG8_WAIT_L(0); PG8_BAR; PG8_MMA(0, 0, At, B0); PG8_MMA(0, 1, At, B1); PG8_BAR; PG8_SCHED;
            PG8_LDA(At, 0, 1); PG8_STAGE(PG8_SB(0, 0), b2, voffB); PG8_STAGE(PG8_SB(0, 1), b2 + hstep, voffB); PG8_STAGE(PG8_SA(0, 0), a2, voffA);
            PG8_WAIT_V(8); PG8_WAIT_L(0); PG8_BAR; PG8_MMA(1, 0, At, B0); PG8_MMA(1, 1, At, B1); PG8_BAR; PG8_SCHED;
            PG8_LDB(B0, 1, 0); PG8_LDB(B1, 1, 1); PG8_SCHED; PG8_LDA(At, 1, 0); PG8_STAGE(PG8_SA(0, 1), a2 + hstep, voffA);
            PG8_WAIT_V(8); PG8_WAIT_L(0); PG8_BAR; PG8_MMA(0, 0, At, B0); PG8_MMA(0, 1, At, B1); PG8_BAR; PG8_SCHED;
            PG8_LDA(At, 1, 1); PG8_STAGE(PG8_SB(1, 0), b3, voffB); PG8_STAGE(PG8_SB(1, 1), b3 + hstep, voffB); PG8_STAGE(PG8_SA(1, 0), a3, voffA);
            PG8_WAIT_V(8); PG8_WAIT_L(0); PG8_BAR; PG8_MMA(1, 0, At, B0); PG8_MMA(1, 1, At, B1); PG8_BAR; PG8_SCHED;
            } else {
            PG8_LDB(B0, 0, 0); PG8_SCHED; PG8_LDA(At, 0, 0); PG8_STAGE(PG8_SA(1, 1), a1 + hstep, voffA);
            PG8_WAIT_L(8); PG8_BAR; PG8_WAIT_L(0); PG8_MMA(0, 0, At, B0); PG8_BAR; PG8_SCHED;
            PG8_LDB(B1, 0, 1); PG8_STAGE(PG8_SB(0, 0), b2, voffB);
            PG8_BAR; PG8_WAIT_L(0); PG8_MMA(0, 1, At, B1); PG8_BAR;
            PG8_LDA(At, 0, 1); PG8_STAGE(PG8_SA(0, 0), a2, voffA);
            PG8_BAR; PG8_WAIT_L(0); PG8_MMA(1, 0, At, B0); PG8_BAR; PG8_SCHED;
            PG8_STAGE(PG8_SB(0, 1), b2 + hstep, voffB);
            PG8_WAIT_V(6); PG8_BAR; PG8_MMA(1, 1, At, B1); PG8_BAR;
            PG8_LDB(B0, 1, 0); PG8_SCHED; PG8_LDA(At, 1, 0); PG8_STAGE(PG8_SA(0, 1), a2 + hstep, voffA);
            PG8_WAIT_L(8); PG8_BAR; PG8_WAIT_L(0); PG8_MMA(0, 0, At, B0); PG8_BAR; PG8_SCHED;
            PG8_LDB(B1, 1, 1); PG8_STAGE(PG8_SB(1, 0), b3, voffB);
            PG8_BAR; PG8_WAIT_L(0); PG8_MMA(0, 1, At, B1); PG8_BAR;
            PG8_LDA(At, 1, 1); PG8_STAGE(PG8_SA(1, 0), a3, voffA);
            PG8_BAR; PG8_WAIT_L(0); PG8_MMA(1, 0, At, B0); PG8_BAR; PG8_SCHED;
            PG8_STAGE(PG8_SB(1, 1), b3 + hstep, voffB);
            PG8_WAIT_V(6); PG8_BAR; PG8_MMA(1, 1, At, B1); PG8_BAR;
            }
        }
        if constexpr (ALIGN_EPI) { if (wr == 0) PG8_BAR; }
        if constexpr (!Epi::AFTER_DRAIN) { E(acc, cur, wr, wc, fr, fq); S.done(cur); }
        if (!has_next) break;
#pragma unroll
        for (int a = 0; a < 2; ++a)
#pragma unroll
            for (int b = 0; b < 2; ++b)
#pragma unroll
                for (int m = 0; m < 4; ++m)
#pragma unroll
                    for (int n = 0; n < 2; ++n) acc[a][b][m][n] = (f32x4){0.f, 0.f, 0.f, 0.f};
        cur = nxt; cA = nA; cB = nB; ++ui;
        if constexpr (ALIGN_EPI) { if (wr == 1) PG8_BAR; }
    }
    PG8_WAIT_V(0);
    if constexpr (!ALIGN_EPI) { if (wr == 0) PG8_BAR; }
    PG8_BAR;
    if constexpr (Epi::AFTER_DRAIN) { E.fused(acc, cur, wr, wc, fr, fq, lds, wid, lane); S.done(cur); }
#undef PG8_SA
#undef PG8_SB
#undef PG8_STAGE
#undef PG8_LDA
#undef PG8_LDB
#undef PG8_MMA
#undef PG8_WAIT_V
#undef PG8_WAIT_L
#undef PG8_BAR
#undef PG8_SCHED
}
}
#include <hip/hip_bf16.h>
#include <cmath>
namespace attn_body {
using bf16=__hip_bfloat16;
using bf16x8=__attribute__((ext_vector_type(8)))short;
using s16x4=__attribute__((ext_vector_type(4)))short;
using f32x16=__attribute__((ext_vector_type(16)))float;
using u32x4=__attribute__((ext_vector_type(4)))unsigned;
using f32x4_t=__attribute__((ext_vector_type(4)))float;
constexpr int D=64,PQ=2304,PO=1024;
constexpr int NW=8,QBLK=32,QB=QBLK*NW,KVBLK=64;
__device__ __forceinline__ int crow(int r,int hi){return (r&3)+8*(r>>2)+4*hi;}
#define SBAR() __builtin_amdgcn_sched_barrier(0)
__device__ __forceinline__ void cmask(f32x16&p0,f32x16&p1,int jb,int qrel,int hi){
  const float NEG=-INFINITY; int kb=64*jb+4*hi;
  #pragma unroll
  for(int r=0;r<16;++r){int kv=kb+(r&3)+8*(r>>2); if(kv>qrel)p0[r]=NEG; if(kv+32>qrel)p1[r]=NEG;}
}

constexpr int NSLOT=3, SLOTB=8192;
constexpr int LDS_K=0, LDS_V=NSLOT*SLOTB, LDS_WS=2*NSLOT*SLOTB, LDS_OST=LDS_WS+NW*64*4, LDS_BYTES=LDS_OST+NW*4096;
constexpr float C2=0.125f*1.4426950408889634f;
__device__ __forceinline__ void glds16(const void*gsrc,unsigned lds_dst){unsigned keep;
  asm volatile("s_mov_b32 %0, m0\n\ts_mov_b32 m0, %2\n\ts_nop 0\n\tglobal_load_lds_dwordx4 %1, off\n\ts_mov_b32 m0, %0":"=&s"(keep):"v"(gsrc),"s"(lds_dst):"memory");}
__device__ __forceinline__ float max3f(float a,float b,float c){float r;asm("v_max3_f32 %0, %1, %2, %3":"=v"(r):"v"(a),"v"(b),"v"(c));return r;}
__device__ __forceinline__ float max2f(float a,float b){float r;asm("v_max_f32_e32 %0, %1, %2":"=v"(r):"v"(a),"v"(b));return r;}
__device__ __forceinline__ float fadd_s(float a,float b){float r;asm("v_add_f32_e32 %0, %1, %2":"=v"(r):"v"(a),"v"(b));return r;}
__device__ __forceinline__ float fsub_s(float a,float b){float r;asm("v_sub_f32_e32 %0, %1, %2":"=v"(r):"v"(a),"v"(b));return r;}
typedef float f32x2_t __attribute__((ext_vector_type(2))); typedef __bf16 bf16x2_t __attribute__((ext_vector_type(2)));
__device__ __forceinline__ unsigned cvtpk_s(float lo,float hi){f32x2_t v={lo,hi};bf16x2_t b=__builtin_convertvector(v,bf16x2_t);return __builtin_bit_cast(unsigned,b);}
#define WAIT_BAR(N) asm volatile("s_waitcnt vmcnt(" #N ") lgkmcnt(0)\n\ts_barrier":::"memory")

__device__ __forceinline__ void qkt(f32x16&p0,f32x16&p1,const char*Kslot,const bf16x8*qr,const f32x16&negm,int r32,int hi){
  const char*kb=Kslot+hi*1024+r32*16;
  #pragma unroll
  for(int d0=0;d0<4;++d0){
    const bf16x8 b0=*reinterpret_cast<const bf16x8*>(kb+d0*2048);
    const bf16x8 b1=*reinterpret_cast<const bf16x8*>(kb+d0*2048+512);
    if(d0==0){p0=__builtin_amdgcn_mfma_f32_32x32x16_bf16(b0,qr[0],negm,0,0,0);p1=__builtin_amdgcn_mfma_f32_32x32x16_bf16(b1,qr[0],negm,0,0,0);}
    else{p0=__builtin_amdgcn_mfma_f32_32x32x16_bf16(b0,qr[d0],p0,0,0,0);p1=__builtin_amdgcn_mfma_f32_32x32x16_bf16(b1,qr[d0],p1,0,0,0);}}
}
typedef __attribute__((address_space(3))) const char* lds_cptr;
typedef short v4i16_t __attribute__((ext_vector_type(4)));
__device__ __forceinline__ void kload8(bf16x8*kf,lds_cptr kp){
  kf[0]=*(const __attribute__((address_space(3))) bf16x8*)(kp);      kf[1]=*(const __attribute__((address_space(3))) bf16x8*)(kp+512);
  kf[2]=*(const __attribute__((address_space(3))) bf16x8*)(kp+2048); kf[3]=*(const __attribute__((address_space(3))) bf16x8*)(kp+2560);
  kf[4]=*(const __attribute__((address_space(3))) bf16x8*)(kp+4096); kf[5]=*(const __attribute__((address_space(3))) bf16x8*)(kp+4608);
  kf[6]=*(const __attribute__((address_space(3))) bf16x8*)(kp+6144); kf[7]=*(const __attribute__((address_space(3))) bf16x8*)(kp+6656);
}
__device__ __forceinline__ void kload2(bf16x8*kf,lds_cptr kp,int j){ kf[2*j]=*(const __attribute__((address_space(3))) bf16x8*)(kp+j*2048); kf[2*j+1]=*(const __attribute__((address_space(3))) bf16x8*)(kp+j*2048+512); }
__device__ __forceinline__ s16x4 vtr(lds_cptr p){ return __builtin_bit_cast(s16x4,__builtin_amdgcn_ds_read_tr16_b64_v4i16((__attribute__((address_space(3))) v4i16_t*)p)); }
__device__ __forceinline__ float rowmax(const f32x16&p0,const f32x16&p1){
  float a=max3f(p0[0],p0[1],p1[0]),b=max3f(p0[2],p0[3],p1[1]);a=max3f(a,p1[2],p1[3]);
  #pragma unroll
  for(int r=4;r<16;r+=4){a=max3f(a,p0[r],p0[r+1]);b=max3f(b,p0[r+2],p0[r+3]);a=max3f(a,p1[r],p1[r+1]);b=max3f(b,p1[r+2],p1[r+3]);}
  const float m=max2f(a,b);
  auto rr=__builtin_amdgcn_permlane32_swap(__float_as_uint(m),__float_as_uint(m),false,false);
  return max2f(__uint_as_float(rr[0]),__uint_as_float(rr[1]));
}
__device__ __forceinline__ void pv(f32x16*o,int vb,bf16x8 pa0,bf16x8 pa1,bf16x8 pa2,bf16x8 pa3){
  #pragma unroll
  for(int d0=0;d0<2;++d0){s16x4 lo[4],hi[4];
    #pragma unroll
    for(int ks=0;ks<4;++ks){
      asm volatile("ds_read_b64_tr_b16 %0,%1 offset:%c2":"=&v"(lo[ks]):"v"(vb),"i"(d0*4096+ks*1024):"memory");
      asm volatile("ds_read_b64_tr_b16 %0,%1 offset:%c2":"=&v"(hi[ks]):"v"(vb),"i"(d0*4096+ks*1024+512):"memory");}
    asm volatile("s_waitcnt lgkmcnt(0)":::"memory");SBAR();
    #define PK(k) (bf16x8){lo[k][0],lo[k][1],lo[k][2],lo[k][3],hi[k][0],hi[k][1],hi[k][2],hi[k][3]}
    o[d0]=__builtin_amdgcn_mfma_f32_32x32x16_bf16(pa0,PK(0),o[d0],0,0,0);
    o[d0]=__builtin_amdgcn_mfma_f32_32x32x16_bf16(pa1,PK(1),o[d0],0,0,0);
    o[d0]=__builtin_amdgcn_mfma_f32_32x32x16_bf16(pa2,PK(2),o[d0],0,0,0);
    o[d0]=__builtin_amdgcn_mfma_f32_32x32x16_bf16(pa3,PK(3),o[d0],0,0,0);
    #undef PK
  }
}

#ifndef ATTN_STORE16
#define ATTN_STORE16(p,v) (*(u32x4*)(p)=(v))
#endif
template<int THRL> __device__ __forceinline__ void attn_unit(long rowbase,int NT,int q0,const bf16*Qh,const bf16*Kc,const bf16*Vc,bf16*Oh,char*shm,const float*rope,const float*qn){
  int tid_l=threadIdx.x; asm volatile("":"+v"(tid_l)); const int tid=tid_l,lane=tid&63,r32=lane&31,hi=lane>>5; const int wid=__builtin_amdgcn_readfirstlane(tid>>6);
  const bf16*Qw=Qh+(rowbase+q0+wid*QBLK)*PQ;
  const bf16*Kh=Kc+rowbase*PQ,*Vh=Vc+rowbase*PQ;
  const unsigned lds0=(unsigned)(uintptr_t)shm;
  float*wsf=(float*)(shm+LDS_WS)+wid*64;
  const bf16*ksrc=Kh+(long)lane*PQ+wid*8;
  const bf16*vsrc=Vh+(long)(16*(wid&3)+(lane>>2))*PQ+(wid>>2)*32+(lane&3)*8;
  const unsigned kdst=lds0+LDS_K+wid*1024, vdst=lds0+LDS_V+wid*1024;
  #define DMA_K(t,slot) glds16(ksrc+(long)(t)*KVBLK*PQ,(unsigned)__builtin_amdgcn_readfirstlane(kdst+(slot)))
  #define DMA_V(t,slot) glds16(vsrc+(long)(t)*KVBLK*PQ,(unsigned)__builtin_amdgcn_readfirstlane(vdst+(slot)))
  const int vb0=(int)(lds0+LDS_V)+((lane>>4)&1)*32+(lane&3)*8+(4*hi+((lane&15)>>2))*64;
  const char*Kbase=shm+LDS_K; bf16x8 kf[8];
  const lds_cptr shm3=(lds_cptr)shm; const lds_cptr kp0=shm3+LDS_K+hi*1024+r32*16; const lds_cptr vp0=shm3+LDS_V+((lane>>4)&1)*32+(lane&3)*8+(4*hi+((lane&15)>>2))*64;
  DMA_K(0,0);DMA_V(0,0);DMA_K(1,SLOTB);
  bf16x8 qr[4];
  #pragma unroll
  for(int d0=0;d0<4;++d0)qr[d0]=*reinterpret_cast<const bf16x8*>(&Qw[(long)r32*PQ+d0*16+hi*8]);
  { float qf[4][8]; float ss=0.f;
    #pragma unroll
    for(int d0=0;d0<4;++d0){
      #pragma unroll
      for(int i=0;i<8;++i){ qf[d0][i]=__uint_as_float(((unsigned)(unsigned short)qr[d0][i])<<16); ss+=qf[d0][i]*qf[d0][i]; } }
    { auto rr=__builtin_amdgcn_permlane32_swap(__float_as_uint(ss),__float_as_uint(ss),false,false); ss=__uint_as_float(rr[0])+__uint_as_float(rr[1]); }
    const float rn=1.f/sqrtf(ss*(1.f/64.f)+1e-6f);
    const float*rp=rope+((long)(q0+wid*QBLK+r32)*32+hi*4)*2;
    #pragma unroll
    for(int d0=0;d0<4;++d0){
      const f32x4_t c01=*reinterpret_cast<const f32x4_t*>(rp+d0*16), c23=*reinterpret_cast<const f32x4_t*>(rp+d0*16+4);
      const f32x4_t g03=*reinterpret_cast<const f32x4_t*>(qn+d0*16+hi*8), g47=*reinterpret_cast<const f32x4_t*>(qn+d0*16+hi*8+4);
      const float cs_[4]={c01[0],c01[2],c23[0],c23[2]}, sn_[4]={c01[1],c01[3],c23[1],c23[3]}, gg[8]={g03[0],g03[1],g03[2],g03[3],g47[0],g47[1],g47[2],g47[3]};
      unsigned w[4];
      #pragma unroll
      for(int j=0;j<4;++j){ const float y0=qf[d0][2*j]*rn*gg[2*j], y1=qf[d0][2*j+1]*rn*gg[2*j+1];
        w[j]=cvtpk_s((y0*cs_[j]-y1*sn_[j])*C2,(y0*sn_[j]+y1*cs_[j])*C2); }
      qr[d0]=__builtin_bit_cast(bf16x8,(u32x4){w[0],w[1],w[2],w[3]}); } }
  float mhat=0.f,l_reg=0.f;f32x16 o[2];f32x16 negm;
  { float zz=0.f; asm volatile("":"+v"(zz));
    _Pragma("unroll") for(int r=0;r<16;++r){o[0][r]=zz;o[1][r]=zz;negm[r]=zz;} }
  asm volatile("":"+v"(negm));
  #define CMASK(P0,P1,t) do{}while(0)
  bool resc=false;
  #define START(P0,P1) do{ const float rm=rowmax(P0,P1); resc=false; \
    { const float dl=rm; mhat=fadd_s(mhat,dl); \
      _Pragma("unroll") for(int r=0;r<16;++r){P0[r]=fsub_s(P0[r],dl);P1[r]=fsub_s(P1[r],dl);} \
      _Pragma("unroll") for(int r=0;r<16;++r)negm[r]=-mhat; asm volatile("":"+v"(negm)); } \
    _Pragma("unroll") for(int r=0;r<16;++r)P0[r]=__builtin_amdgcn_exp2f(P0[r]); }while(0)
  #define RESC() do{ if(resc){ asm volatile("s_waitcnt lgkmcnt(0)":::"memory"); \
      _Pragma("unroll") for(int d_=0;d_<2;++d_) _Pragma("unroll") for(int r=0;r<16;++r)o[d_][r]*=wsf[crow(r,hi)]; } }while(0)
  f32x16 pA0,pA1,pB0,pB1;
  int sl_prev=0,sl_cur=0,sl_next=SLOTB;
  #define ROT() do{sl_prev=sl_cur;sl_cur=sl_next;sl_next=(sl_next==(NSLOT-1)*SLOTB)?0:sl_next+SLOTB;}while(0)
  DMA_K(2,2*SLOTB);
  WAIT_BAR(3);
  qkt(pA0,pA1,Kbase,qr,negm,r32,hi);asm volatile("s_nop 15\n\ts_nop 7":"+v"(pA0),"+v"(pA1));CMASK(pA0,pA1,0);
  START(pA0,pA1);
  _Pragma("unroll") for(int r=0;r<16;++r)pA1[r]=__builtin_amdgcn_exp2f(pA1[r]);
  WAIT_BAR(0);
  DMA_K(3,0);DMA_V(1,SLOTB);
  ROT();
  kload8(kf,kp0+sl_cur);
  WAIT_BAR(2);
  s16x4 vlo[8],vhi[8]; u32x4 pw0,pw1,pw2,pw3;
  #define PKW(P,B) cvtpk_s(P[B],P[B+1])
  #define PAF(k) __builtin_bit_cast(bf16x8,pw##k)
  #define VFR(i) (bf16x8){vlo[i][0],vlo[i][1],vlo[i][2],vlo[i][3],vhi[i][0],vhi[i][1],vhi[i][2],vhi[i][3]}
  #define PIN(x) asm volatile("":"+v"(x))
  #define MX3(a,b,c) __builtin_fmaxf(__builtin_fmaxf((a),(b)),(c))
  #define GAPA(MF,A0,A1,A2,A3,W0,W1,PW) do{ MF; sacc+=A0; sacc+=A1; sacc+=A2; sacc+=A3; PIN(sacc); W0; W1; PIN(PW); SBAR(); }while(0)
  #define EX(v) __builtin_amdgcn_exp2f(v)
  #define GAPB(MF,X,B) do{ MF; X[B]=EX(X[B]); X[B+1]=EX(X[B+1]); X[B+2]=EX(X[B+2]); X[B+3]=EX(X[B+3]); PIN(X); SBAR(); }while(0)
  #define VRD(i) do{ vlo[i]=vtr(vp_+(((i)>>2)*4096+((i)&3)*1024)); vhi[i]=vtr(vp_+(((i)>>2)*4096+((i)&3)*1024+512)); }while(0)
  #define KRD(G,j) do{ if(G){ kload2(kf,kp0+sl_next,j); SBAR(); } }while(0)
  #define STEP(C0,C1,P0,P1,t,GK,GV,GL) do{ SBAR(); \
    const lds_cptr vp_=vp0+sl_prev; \
    VRD(0); SBAR(); float sacc=(P0[0]+P0[1]); \
    GAPA(C0=__builtin_amdgcn_mfma_f32_32x32x16_bf16(kf[0],qr[0],negm,0,0,0), P0[2],P0[3],P0[4],P0[5],     pw0[0]=PKW(P0,0), pw0[1]=PKW(P0,2), pw0); \
    VRD(4); SBAR(); GAPA(C1=__builtin_amdgcn_mfma_f32_32x32x16_bf16(kf[1],qr[0],negm,0,0,0), P0[6],P0[7],P0[8],P0[9],     pw0[2]=PKW(P0,4), pw0[3]=PKW(P0,6), pw0); \
    VRD(1); SBAR(); GAPA(C0=__builtin_amdgcn_mfma_f32_32x32x16_bf16(kf[2],qr[1],C0,0,0,0),   P0[10],P0[11],P0[12],P0[13], pw1[0]=PKW(P0,8), pw1[1]=PKW(P0,10), pw1); \
    VRD(5); SBAR(); GAPA(C1=__builtin_amdgcn_mfma_f32_32x32x16_bf16(kf[3],qr[1],C1,0,0,0),   P0[14],P0[15],P1[0],P1[1],   pw1[2]=PKW(P0,12),pw1[3]=PKW(P0,14), pw1); \
    VRD(2); SBAR(); GAPA(C0=__builtin_amdgcn_mfma_f32_32x32x16_bf16(kf[4],qr[2],C0,0,0,0),   P1[2],P1[3],P1[4],P1[5],     pw2[0]=PKW(P1,0), pw2[1]=PKW(P1,2), pw2); \
    VRD(6); SBAR(); GAPA(C1=__builtin_amdgcn_mfma_f32_32x32x16_bf16(kf[5],qr[2],C1,0,0,0),   P1[6],P1[7],P1[8],P1[9],     pw2[2]=PKW(P1,4), pw2[3]=PKW(P1,6), pw2); \
    VRD(3); SBAR(); GAPA(C0=__builtin_amdgcn_mfma_f32_32x32x16_bf16(kf[6],qr[3],C0,0,0,0),   P1[10],P1[11],P1[12],P1[13], pw3[0]=PKW(P1,8), pw3[1]=PKW(P1,10), pw3); \
    VRD(7); SBAR(); GAPA(C1=__builtin_amdgcn_mfma_f32_32x32x16_bf16(kf[7],qr[3],C1,0,0,0),   P1[14],P1[15],0.f,0.f,       pw3[2]=PKW(P1,12),pw3[3]=PKW(P1,14), pw3); \
    l_reg+=sacc; \
    if(GK){DMA_K((t)+3,sl_cur);} if(GV){DMA_V((t)+1,sl_next);} \
    CMASK(C0,C1,t); \
    { float a=MX3(C0[0],C0[1],C1[0]),b=MX3(C0[2],C0[3],C1[1]); a=MX3(a,C1[2],C1[3]); \
      _Pragma("unroll") for(int r=4;r<16;r+=4){a=MX3(a,C0[r],C0[r+1]);b=MX3(b,C0[r+2],C0[r+3]);a=MX3(a,C1[r],C1[r+1]);b=MX3(b,C1[r+2],C1[r+3]);} \
      float rm=__builtin_fmaxf(a,b); { auto rr=__builtin_amdgcn_permlane32_swap(__float_as_uint(rm),__float_as_uint(rm),false,false); rm=__builtin_fmaxf(__uint_as_float(rr[0]),__uint_as_float(rr[1])); } \
      resc=false; \
      if(__builtin_expect(__any(rm>(float)THRL),0)){ const float dl=__builtin_fmaxf(rm,0.f); mhat+=dl; \
        _Pragma("unroll") for(int r=0;r<16;++r){C0[r]-=dl;C1[r]-=dl;} \
        _Pragma("unroll") for(int r=0;r<16;++r)negm[r]=-mhat; asm volatile("":"+v"(negm)); \
        const float f=__builtin_amdgcn_exp2f(-dl); l_reg*=f; if(hi==0)wsf[r32]=f; resc=true; } } \
    SBAR(); \
    GAPB(o[0]=__builtin_amdgcn_mfma_f32_32x32x16_bf16(PAF(0),VFR(0),o[0],0,0,0), C0,0); \
    GAPB(o[1]=__builtin_amdgcn_mfma_f32_32x32x16_bf16(PAF(0),VFR(4),o[1],0,0,0), C0,4); \
    KRD(GL,0); GAPB(o[0]=__builtin_amdgcn_mfma_f32_32x32x16_bf16(PAF(1),VFR(1),o[0],0,0,0), C0,8); \
    KRD(GL,1); GAPB(o[1]=__builtin_amdgcn_mfma_f32_32x32x16_bf16(PAF(1),VFR(5),o[1],0,0,0), C0,12); \
    KRD(GL,2); GAPB(o[0]=__builtin_amdgcn_mfma_f32_32x32x16_bf16(PAF(2),VFR(2),o[0],0,0,0), C1,0); \
    KRD(GL,3); GAPB(o[1]=__builtin_amdgcn_mfma_f32_32x32x16_bf16(PAF(2),VFR(6),o[1],0,0,0), C1,4); \
    GAPB(o[0]=__builtin_amdgcn_mfma_f32_32x32x16_bf16(PAF(3),VFR(3),o[0],0,0,0), C1,8); \
    GAPB(o[1]=__builtin_amdgcn_mfma_f32_32x32x16_bf16(PAF(3),VFR(7),o[1],0,0,0), C1,12); \
    }while(0)
  int t=1;
  for(;t+5<NT;t+=2){
    STEP(pB0,pB1,pA0,pA1,t,true,true,true);     WAIT_BAR(2); RESC(); ROT();
    STEP(pA0,pA1,pB0,pB1,t+1,true,true,true);   WAIT_BAR(2); RESC(); ROT();
  }
  #define ENDW(tt) do{ if((tt)+3<NT){WAIT_BAR(2);} else if((tt)+2<NT){WAIT_BAR(1);} else {WAIT_BAR(0);} }while(0)
  for(;t+1<NT;t+=2){
    STEP(pB0,pB1,pA0,pA1,t,(t+3<NT),(t+1<NT),(t+1<NT));       ENDW(t);   RESC(); ROT();
    STEP(pA0,pA1,pB0,pB1,t+1,(t+4<NT),(t+2<NT),(t+2<NT));     ENDW(t+1); RESC(); ROT();
  }
  STEP(pB0,pB1,pA0,pA1,NT-1,false,false,false); RESC();
  { float sacc=pB0[0]+pB0[1]; _Pragma("unroll") for(int r=2;r<16;++r)sacc+=pB0[r]; _Pragma("unroll") for(int r=0;r<16;++r)sacc+=pB1[r]; l_reg+=sacc;
    pw0=(u32x4){PKW(pB0,0),PKW(pB0,2),PKW(pB0,4),PKW(pB0,6)};pw1=(u32x4){PKW(pB0,8),PKW(pB0,10),PKW(pB0,12),PKW(pB0,14)};pw2=(u32x4){PKW(pB1,0),PKW(pB1,2),PKW(pB1,4),PKW(pB1,6)};pw3=(u32x4){PKW(pB1,8),PKW(pB1,10),PKW(pB1,12),PKW(pB1,14)};
    SBAR(); pv(o,vb0+sl_cur,PAF(0),PAF(1),PAF(2),PAF(3)); }
  #undef PKW
  #undef PAF
  #undef VFR
  #undef PIN
  #undef MX3
  #undef GAPA
  #undef GAPB
  #undef EX
  #undef VRD
  #undef KRD
  #undef STEP
  #undef ENDW
  {auto rr=__builtin_amdgcn_permlane32_swap(__float_as_uint(l_reg),__float_as_uint(l_reg),false,false);l_reg=__uint_as_float(rr[0])+__uint_as_float(rr[1]);}
  if(hi==0)wsf[32+r32]=l_reg;asm volatile("s_waitcnt lgkmcnt(0)":::"memory");
  float rli[16];
  #pragma unroll
  for(int r=0;r<16;++r)rli[r]=__builtin_amdgcn_rcpf(wsf[32+crow(r,hi)]);
  bf16*Ow=Oh+(rowbase+q0+wid*QBLK)*PO;
  { bf16*stg=(bf16*)(shm+LDS_OST)+wid*2048;
    #pragma unroll
    for(int r=0;r<16;++r){const int orow=crow(r,hi);
      #pragma unroll
      for(int d0=0;d0<2;++d0)stg[orow*64+d0*32+r32]=__float2bfloat16(o[d0][r]*rli[r]);}
    asm volatile("s_waitcnt lgkmcnt(0)":::"memory");
    #pragma unroll
    for(int i=0;i<4;++i){const int row=i*8+(lane>>3),ch=lane&7; const u32x4 v=*(const u32x4*)(stg+row*64+ch*8); ATTN_STORE16(Ow+(long)row*PO+ch*8,v);} }
  asm volatile("s_waitcnt lgkmcnt(0)\n\ts_barrier":::"memory");
  #undef DMA_K
  #undef DMA_V
  #undef CMASK
  #undef START
  #undef RESC
  #undef ROT
}
constexpr int ATTN_LDS_BYTES=LDS_BYTES;
#undef SBAR
#undef WAIT_BAR
}
namespace mk {
typedef unsigned short bf16_t;
typedef unsigned u32x4 __attribute__((ext_vector_type(4)));
typedef float f32x4 __attribute__((ext_vector_type(4)));
typedef float f2v __attribute__((ext_vector_type(2)));
#define LAS __attribute__((address_space(3)))
constexpr int DM = 1024, MTOK = 65536, MHALF = 32768, INW = 2304, DFF = 2816, UPW = 5632, NLAYER = 4;
constexpr float ALPHA = 1.6817928305074290f, LN_EPS = 1e-6f;
constexpr size_t MiB = 1u << 20;
constexpr size_t WS_ROPE = 1 * MiB, WS_W = 4 * MiB, W_LAYER = 23 * MiB, W_IN = 0, W_O = 4608 * 1024, W_UP = 6656 * 1024, W_DOWN = 17920 * 1024;
constexpr size_t WS_XBF = 96 * MiB, WS_Z = 224 * MiB, WS_MIX = 512 * MiB, WS_H = 224 * MiB  , WS_EDGE = 640 * MiB, WS_SPA = 664 * MiB, WS_SPB = 672 * MiB  ,
                 WS_CDIN = 680 * MiB  , WS_CDUP = 681 * MiB  , WS_PIN = 682 * MiB  , WS_PUP = 684 * MiB  , WS_ONES = 688 * MiB, WS_EDGE2 = 689 * MiB  , WS_BAR = 0  , WS_END = 692 * MiB;
constexpr int BARST_OFF = 131072;
constexpr int ST_OFF = 131072 + 1024 + 8192;
constexpr int HALO_OFF = 131072 + 1024;
constexpr int LDS_BYTES = 147456;

__device__ __forceinline__ float bf2f(unsigned b) { return __uint_as_float(b << 16); }
__device__ __forceinline__ unsigned pk(float lo, float hi) { return pg8::cvt_pk_bf16(lo, hi); }
__device__ __forceinline__ unsigned pkh(float lo, float hi) { return pg8::cvt_pk_f16(lo, hi); }
__device__ __forceinline__ float h2f(unsigned b) { return (float)__builtin_bit_cast(_Float16, (unsigned short)b); }
__device__ __forceinline__ void unpack8h(u32x4 w, float* f) { f[0] = h2f(w.x & 0xffffu); f[1] = h2f(w.x >> 16); f[2] = h2f(w.y & 0xffffu); f[3] = h2f(w.y >> 16);
    f[4] = h2f(w.z & 0xffffu); f[5] = h2f(w.z >> 16); f[6] = h2f(w.w & 0xffffu); f[7] = h2f(w.w >> 16); }
__device__ __forceinline__ void unpack8(u32x4 w, float* f) { f[0] = bf2f(w.x & 0xffffu); f[1] = bf2f(w.x >> 16); f[2] = bf2f(w.y & 0xffffu); f[3] = bf2f(w.y >> 16);
    f[4] = bf2f(w.z & 0xffffu); f[5] = bf2f(w.z >> 16); f[6] = bf2f(w.w & 0xffffu); f[7] = bf2f(w.w >> 16); }
template <int O> __device__ __forceinline__ float swz_xor(float v) { return __int_as_float(__builtin_amdgcn_ds_swizzle(__float_as_int(v), (O << 10) | 0x1f)); }
__device__ __forceinline__ float half_sum(float v) { v += swz_xor<1>(v); v += swz_xor<2>(v); v += swz_xor<4>(v); v += swz_xor<8>(v); v += swz_xor<16>(v); return v; }
__device__ __forceinline__ float wave_sum(float v) { v = half_sum(v); auto rr = __builtin_amdgcn_permlane32_swap(__float_as_uint(v), __float_as_uint(v), false, false); return __uint_as_float(rr[0]) + __uint_as_float(rr[1]); }
__device__ __forceinline__ void transpose_item(const float* W, int K, int N, bf16_t* WT, int pbase, int phalf, const float* gvec, const float* bvec, float2* PART, LAS float* scr, int item, int lane, bool f16 = false) {
    const int nblk = N / 32, kb = item / nblk, nb = item % nblk, k0 = 64 * kb, n0 = 32 * nb;
    int d0 = n0;
    if (phalf && n0 >= pbase) { const int v = (n0 - pbase) >= phalf ? 1 : 0, nn = n0 - pbase - v * phalf; d0 = pbase + 256 * (nn / 128) + 128 * v + (nn % 128); }
#pragma unroll 8
    for (int i = 0; i < 32; ++i) { const int kk = 2 * i + (lane >> 5); scr[kk * 33 + (lane & 31)] = W[(size_t)(k0 + kk) * N + n0 + (lane & 31)]; }
    asm volatile("s_waitcnt lgkmcnt(0)" ::: "memory");
    const int c = lane & 7;
    float gk[8], bk[8];
#pragma unroll
    for (int q = 0; q < 8; ++q) { gk[q] = gvec ? gvec[k0 + 8 * c + q] : 1.f; bk[q] = gvec ? bvec[k0 + 8 * c + q] : 0.f; }
#pragma unroll
    for (int j = 0; j < 4; ++j) { const int n = (lane >> 3) + 8 * j; const LAS float* sp = scr + (8 * c) * 33 + n;
        float w[8]; float ds = 0.f;
#pragma unroll
        for (int q = 0; q < 8; ++q) { const float x = sp[q * 33]; ds += bk[q] * x; w[q] = gk[q] * x; }
        u32x4 o; if (f16) { o.x = pkh(w[0], w[1]); o.y = pkh(w[2], w[3]); o.z = pkh(w[4], w[5]); o.w = pkh(w[6], w[7]); } else { o.x = pk(w[0], w[1]); o.y = pk(w[2], w[3]); o.z = pk(w[4], w[5]); o.w = pk(w[6], w[7]); }
        *(u32x4*)(WT + (size_t)(d0 + n) * K + k0 + 8 * c) = o;
        if (PART) {
            float r8[8]; if (f16) unpack8h(o, r8); else unpack8(o, r8);
            float cs = ((r8[0] + r8[1]) + (r8[2] + r8[3])) + ((r8[4] + r8[5]) + (r8[6] + r8[7]));
            cs += swz_xor<1>(cs); cs += swz_xor<2>(cs); cs += swz_xor<4>(cs); ds += swz_xor<1>(ds); ds += swz_xor<2>(ds); ds += swz_xor<4>(ds);
            if (c == 0) PART[(size_t)kb * N + d0 + n] = make_float2(cs, ds);
        }
    }
    asm volatile("s_waitcnt lgkmcnt(0)" ::: "memory");
}
template <bool NORM, bool WF32 = true, bool WB16 = true> __device__ __forceinline__ void row_pass(const float* src, float* dstf, bf16_t* dstb, const float* g, const float* b, int lane) {
    const f32x4* xr = (const f32x4*)src + lane;
    f32x4 v[4]; float s = 0.f;
#pragma unroll
    for (int j = 0; j < 4; ++j) { v[j] = xr[64 * j]; s += (v[j].x + v[j].y) + (v[j].z + v[j].w); }
    if (NORM) {
        const float mean = wave_sum(s) * (1.f / DM); float s2 = 0.f;
#pragma unroll
        for (int j = 0; j < 4; ++j) { v[j] = v[j] - mean; s2 += (v[j].x * v[j].x + v[j].y * v[j].y) + (v[j].z * v[j].z + v[j].w * v[j].w); }
        const float rstd = 1.f / sqrtf(wave_sum(s2) * (1.f / DM) + LN_EPS);
#pragma unroll
        for (int j = 0; j < 4; ++j) { const f32x4 gg = ((const f32x4*)g)[lane + 64 * j], bb = ((const f32x4*)b)[lane + 64 * j]; v[j] = v[j] * rstd * gg + bb; }
    }
    f32x4* of = (f32x4*)dstf + lane; unsigned long long* ob = (unsigned long long*)dstb + lane;
#pragma unroll
    for (int j = 0; j < 4; ++j) { if (WF32) of[64 * j] = v[j]; if (WB16) ob[64 * j] = (unsigned long long)pkh(v[j].x, v[j].y) | ((unsigned long long)pkh(v[j].z, v[j].w) << 32); }
}
__device__ __forceinline__ void tokpos(int m, int& t, int& S) { if (m < MHALF) { S = 4096; t = m & 4095; } else { S = 8192; t = (m - MHALF) & 8191; } }
__device__ __forceinline__ void prep_row(bf16_t* z, bf16_t* mix, int m, int lane, const float2* rope, const float* qn, const float* kn, const float* cw, const float* cb) {
    int t, S; tokpos(m, t, S);
    bf16_t* zr = z + (size_t)m * INW;
    const int p = lane & 31, hh = lane >> 5;
    const float2 cs = rope[t * 32 + p];
    const float gq0 = qn[2 * p], gq1 = qn[2 * p + 1], gk0 = kn[2 * p], gk1 = kn[2 * p + 1];
    {
        const int head = 8 + hh; unsigned* wp = (unsigned*)(zr + head * 64 + 2 * p); const unsigned w = *wp;
        const float x0 = bf2f(w & 0xffffu), x1 = bf2f(w >> 16);
        float ss = x0 * x0 + x1 * x1;
        ss = half_sum(ss);
        const float r = 1.f / sqrtf(ss * (1.f / 64.f) + LN_EPS);
        const bool isq = head < 8;
        const float y0 = x0 * r * (isq ? gq0 : gk0), y1 = x1 * r * (isq ? gq1 : gk1);
        float o0 = y0 * cs.x - y1 * cs.y, o1 = y0 * cs.y + y1 * cs.x;
        if (isq) { o0 *= attn_body::C2; o1 *= attn_body::C2; }
        *wp = pk(o0, o1);
    }
}
__device__ __forceinline__ void conv_mix_unit(const bf16_t* Z, bf16_t* mix, const float* E2, const float* cw, const float* cbias, long row0, int h, int t0, int S, int tid) {
    const int pm = (int)(row0 >> 8);
#pragma unroll
    for (int it = 0; it < 4; ++it) {
        const int idx = tid + 512 * it, r = idx >> 3, ch = h * 64 + (idx & 7) * 8; const size_t row = (size_t)row0 + r;
        float fb[8], cp[8];
        unpack8(*(const u32x4*)(Z + row * INW + 768 + ch), fb);
        if (r == 0 || r == 255) {
            const float* Ep = E2 + (size_t)pm * 4 * 512 + ch; const bool last = r == 255;
            const float* r0 = last ? Ep + 2 * 512 : Ep - 512; const float* r1 = last ? Ep + 3 * 512 : Ep; const float* r2 = last ? Ep + 4 * 512 : Ep + 512;
            const bool hasp = t0 + r > 0, hasn = t0 + r < S - 1;
#pragma unroll
            for (int i = 0; i < 8; ++i) cp[i] = cw[ch + i] * (hasp ? r0[i] : 0.f) + cw[512 + ch + i] * r1[i] + cw[1024 + ch + i] * (hasn ? r2[i] : 0.f) + cbias[ch + i];
        } else unpack8(*(const u32x4*)(Z + row * INW + 1280 + ch), cp);
        u32x4 w; w.x = pk(fb[0] * cp[0], fb[1] * cp[1]); w.y = pk(fb[2] * cp[2], fb[3] * cp[3]); w.z = pk(fb[4] * cp[4], fb[5] * cp[5]); w.w = pk(fb[6] * cp[6], fb[7] * cp[7]);
        *(u32x4*)(mix + row * DM + 512 + ch) = w;
    }
}
__device__ __forceinline__ void row_stats_to_lds(const float* SP, int pm, LAS f2v* T, int tid) {
    if (tid < 256) { const f32x4* p = (const f32x4*)(SP + (size_t)(pm * 256 + tid) * 32); float s1 = 0.f, s2 = 0.f;
#pragma unroll
        for (int k = 0; k < 8; ++k) { const f32x4 v = p[k]; s1 += v.x + v.z; s2 += v.y + v.w; }
        const float mu = s1 * (1.f / DM), var = s2 * (1.f / DM) - mu * mu;
        T[tid] = (f2v){mu, 1.f / sqrtf(var + LN_EPS)}; }
    asm volatile("s_waitcnt lgkmcnt(0)" ::: "memory"); __builtin_amdgcn_s_barrier(); asm volatile("" ::: "memory");
}
#define DPPF(old, src, ctrl) __int_as_float(__builtin_amdgcn_update_dpp(__float_as_int(old), __float_as_int(src), (ctrl), 0xf, 0xf, false))
#define DPPZ(src, ctrl) __int_as_float(__builtin_amdgcn_update_dpp(0, __float_as_int(src), (ctrl), 0xf, 0xf, true))
__device__ __forceinline__ float silu_mul(float G, float V) { return G * __builtin_amdgcn_rcpf(1.f + __builtin_amdgcn_exp2f(-1.4426950408889634f * G)) * V; }
struct EpiFfn {
    static constexpr bool PERM = true, AFTER_DRAIN = false;
    bf16_t* H; float* E; const float* fw; const float* fb; LAS float* R; const float* SP; const float* cvec; const float* dvec; LAS f2v* T; mutable int last_pm;
    __device__ __forceinline__ void operator()(pg8::f32x4 (&acc)[2][2][4][2], const pg8::Unit& u, int wr, int wc, int fr, int fq) const {
        typedef pg8::f32x4 f4;
        const int cidx = (wc * 4 + fq) * 16, cl = 32 * wc + 8 * fq;
        if (u.pm != last_pm) { row_stats_to_lds(SP, u.pm, T, (wr * 4 + wc) * 64 + fq * 16 + fr); last_pm = u.pm; }
#pragma unroll
        for (int bj = 0; bj < 2; ++bj)
#pragma unroll
            for (int n = 0; n < 2; ++n) { const f4 cv = *(const f4*)(cvec + u.pn * 256 + 128 * bj + cl + 4 * n), dv = *(const f4*)(dvec + u.pn * 256 + 128 * bj + cl + 4 * n);
#pragma unroll
                for (int ai = 0; ai < 2; ++ai)
#pragma unroll
                    for (int m = 0; m < 4; ++m) { const f2v st = T[ai * 128 + wr * 64 + m * 16 + fr]; acc[ai][bj][m][n] = acc[ai][bj][m][n] * st.y + (cv * (-st.x * st.y) + dv); } }
#pragma unroll
        for (int ai = 0; ai < 2; ++ai) { const int s = 2 * ai + wr;
            if (fr == 0) {
#pragma unroll
                for (int bj = 0; bj < 2; ++bj)
#pragma unroll
                    for (int n = 0; n < 2; ++n) *(LAS f4*)(R + (2 * s) * 256 + cidx + (bj * 2 + n) * 4) = acc[ai][bj][0][n]; }
            if (fr == 15) {
#pragma unroll
                for (int bj = 0; bj < 2; ++bj)
#pragma unroll
                    for (int n = 0; n < 2; ++n) *(LAS f4*)(R + (2 * s + 1) * 256 + cidx + (bj * 2 + n) * 4) = acc[ai][bj][3][n]; } }
        { float* Eb = E + (size_t)u.pm * 4 * UPW + u.pn * 256 + cl;
            if (wr == 0 && fr < 2) {
#pragma unroll
                for (int bj = 0; bj < 2; ++bj)
#pragma unroll
                    for (int n = 0; n < 2; ++n) *(f4*)(Eb + fr * UPW + 128 * bj + 4 * n) = acc[0][bj][0][n]; }
            if (wr == 1 && fr >= 14) {
#pragma unroll
                for (int bj = 0; bj < 2; ++bj)
#pragma unroll
                    for (int n = 0; n < 2; ++n) *(f4*)(Eb + (fr - 12) * UPW + 128 * bj + 4 * n) = acc[1][bj][3][n]; } }
        asm volatile("s_waitcnt lgkmcnt(0)" ::: "memory"); __builtin_amdgcn_s_barrier(); asm volatile("" ::: "memory");
#pragma unroll
        for (int n = 0; n < 2; ++n) {
            const int chg = 128 * u.pn + cl + 4 * n;
            const f4 w0g = *(const f4*)(fw + chg), w1g = *(const f4*)(fw + UPW + chg), w2g = *(const f4*)(fw + 2 * UPW + chg), bg = *(const f4*)(fb + chg);
            const f4 w0v = *(const f4*)(fw + DFF + chg), w1v = *(const f4*)(fw + UPW + DFF + chg), w2v = *(const f4*)(fw + 2 * UPW + DFF + chg), bv = *(const f4*)(fb + DFF + chg);
#pragma unroll
            for (int ai = 0; ai < 2; ++ai) { const int s = 2 * ai + wr;
                const int ra = (s > 0 ? 2 * s - 1 : 0) * 256 + cidx + n * 4, rb = (s < 3 ? 2 * s + 2 : 7) * 256 + cidx + n * 4;
                const f4 abg = *(const LAS f4*)(R + ra), abv = *(const LAS f4*)(R + ra + 8), beg = *(const LAS f4*)(R + rb), bev = *(const LAS f4*)(R + rb + 8);
#pragma unroll
                for (int e = 0; e < 4; ++e) {
                    float opg = 0.f, opv = 0.f;
#pragma unroll
                    for (int m = 0; m < 4; ++m) {
                        const float cg_ = acc[ai][0][m][n][e], cv_ = acc[ai][1][m][n][e];
                        float tg, tv, ng, nv;
                        if (m == 0) { tg = abg[e]; tv = abv[e]; } else { tg = DPPZ(opg, 0x10F); tv = DPPZ(opv, 0x10F); }
                        if (m == 3) { ng = beg[e]; nv = bev[e]; } else { ng = DPPZ(acc[ai][0][m + 1][n][e], 0x11F); nv = DPPZ(acc[ai][1][m + 1][n][e], 0x11F); }
                        const float pg_ = DPPF(tg, cg_, 0x111), pv_ = DPPF(tv, cv_, 0x111);
                        const float xg_ = DPPF(ng, cg_, 0x101), xv_ = DPPF(nv, cv_, 0x101);
                        const float Gv = w0g[e] * pg_ + w1g[e] * cg_ + w2g[e] * xg_ + bg[e];
                        const float Vv = w0v[e] * pv_ + w1v[e] * cv_ + w2v[e] * xv_ + bv[e];
                        opg = cg_; opv = cv_;
                        acc[ai][0][m][n][e] = silu_mul(Gv, Vv);
                    }
                    __builtin_amdgcn_sched_barrier(0);
                }
            }
        }
#pragma unroll
        for (int ai = 0; ai < 2; ++ai)
#pragma unroll
            for (int m = 0; m < 4; ++m) { bf16_t* p = H + (size_t)(u.pm * pg8::BM + ai * pg8::HALF + wr * 64 + m * 16 + fr) * DFF + 128 * u.pn + cl;
                const f4 v0 = acc[ai][0][m][0], v1 = acc[ai][0][m][1];
                u32x4 w; w.x = pk(v0[0], v0[1]); w.y = pk(v0[2], v0[3]); w.z = pk(v1[0], v1[1]); w.w = pk(v1[2], v1[3]);
                *(u32x4*)p = w; }
    }
};
__device__ __forceinline__ void ffn_fix_item(const float* E, bf16_t* H, int pm, int which, int ch, const float* fw, const float* fb) {
    const int m = pm * 256 + (which ? 255 : 0); int t, S; tokpos(m, t, S);
    const int j = ch >> 4, i8 = (ch & 15) * 8, ucg = 256 * j + i8, cg_ = 128 * j + i8, cv_ = DFF + cg_;
    const float* Ep = E + (size_t)pm * 4 * UPW + ucg;
    const float* r0 = which ? Ep + 2 * UPW : Ep - UPW;
    const float* r1 = which ? Ep + 3 * UPW : Ep;
    const float* r2 = which ? Ep + 4 * UPW : Ep + UPW;
    const bool hasp = t > 0, hasn = t < S - 1;
    float o[8];
#pragma unroll
    for (int i = 0; i < 8; ++i) {
        const float gm = hasp ? r0[i] : 0.f, vm = hasp ? r0[128 + i] : 0.f, gp = hasn ? r2[i] : 0.f, vp = hasn ? r2[128 + i] : 0.f;
        const float G = fw[cg_ + i] * gm + fw[UPW + cg_ + i] * r1[i] + fw[2 * UPW + cg_ + i] * gp + fb[cg_ + i];
        const float V = fw[cv_ + i] * vm + fw[UPW + cv_ + i] * r1[128 + i] + fw[2 * UPW + cv_ + i] * vp + fb[cv_ + i];
        o[i] = silu_mul(G, V);
    }
    u32x4 w; w.x = pk(o[0], o[1]); w.y = pk(o[2], o[3]); w.z = pk(o[4], o[5]); w.w = pk(o[6], o[7]);
    *(u32x4*)(H + (size_t)m * DFF + cg_) = w;
}
struct EpiZ {
    static constexpr bool PERM = true, AFTER_DRAIN = false;
    bf16_t* O; const float* SP; const float* cvec; const float* dvec; LAS f2v* T; float* E2; const float* cw; const float* cbias; LAS float* R; const float* rope; const float* kn; mutable int last_pm;
    __device__ __forceinline__ void store_tile(const pg8::f32x4 (&acc)[2][2][4][2], const pg8::Unit& u, int wr, int wc, int fr, int fq) const {
        typedef pg8::f32x4 f4;
        asm volatile("" : "+v"(fr));
        const int cbs = u.pn * 256 + wc * 32 + 8 * fq;
#pragma unroll
        for (int ai = 0; ai < 2; ++ai)
#pragma unroll
            for (int m = 0; m < 4; ++m) { bf16_t* rowp = O + (size_t)(u.pm * 256 + ai * 128 + wr * 64 + m * 16 + fr) * INW + cbs;
#pragma unroll
                for (int bj = 0; bj < 2; ++bj) { const f4 v0 = acc[ai][bj][m][0], v1 = acc[ai][bj][m][1];
                    u32x4 w; w.x = pk(v0[0], v0[1]); w.y = pk(v0[2], v0[3]); w.z = pk(v1[0], v1[1]); w.w = pk(v1[2], v1[3]);
                    *(u32x4*)(rowp + bj * 128) = w; } }
    }
    __device__ __forceinline__ void conv_tile(pg8::f32x4 (&acc)[2][2][4][2], const pg8::Unit& u, int wr, int wc, int fr, int fq) const {
        typedef pg8::f32x4 f4;
        const int cidx = (wc * 4 + fq) * 8, cl = 32 * wc + 8 * fq, jt = u.pn - 5;
#pragma unroll
        for (int ai = 0; ai < 2; ++ai)
#pragma unroll
            for (int m = 0; m < 4; ++m)
#pragma unroll
                for (int n = 0; n < 2; ++n) acc[ai][0][m][n] = acc[ai][0][m][n] * acc[ai][1][m][n];
#pragma unroll
        for (int ai = 0; ai < 2; ++ai) { const int s = 2 * ai + wr;
            if (fr == 0) {
#pragma unroll
                for (int n = 0; n < 2; ++n) *(LAS f4*)(R + (2 * s) * 128 + cidx + n * 4) = acc[ai][0][0][n]; }
            if (fr == 15) {
#pragma unroll
                for (int n = 0; n < 2; ++n) *(LAS f4*)(R + (2 * s + 1) * 128 + cidx + n * 4) = acc[ai][0][3][n]; } }
        { float* Eb = E2 + (size_t)u.pm * 4 * 512 + jt * 128 + cl;
            if (wr == 0 && fr < 2) {
#pragma unroll
                for (int n = 0; n < 2; ++n) *(f4*)(Eb + fr * 512 + 4 * n) = acc[0][0][0][n]; }
            if (wr == 1 && fr >= 14) {
#pragma unroll
                for (int n = 0; n < 2; ++n) *(f4*)(Eb + (fr - 12) * 512 + 4 * n) = acc[1][0][3][n]; } }
        asm volatile("s_waitcnt lgkmcnt(0)" ::: "memory"); __builtin_amdgcn_s_barrier(); asm volatile("" ::: "memory");
#pragma unroll
        for (int n = 0; n < 2; ++n) {
            const int ch = 128 * jt + cl + 4 * n;
            const f4 w0 = *(const f4*)(cw + ch), w1 = *(const f4*)(cw + 512 + ch), w2 = *(const f4*)(cw + 1024 + ch), bb = *(const f4*)(cbias + ch);
#pragma unroll
            for (int ai = 0; ai < 2; ++ai) { const int s = 2 * ai + wr;
                const int ra = (s > 0 ? 2 * s - 1 : 0) * 128 + cidx + n * 4, rb = (s < 3 ? 2 * s + 2 : 7) * 128 + cidx + n * 4;
                const f4 ab = *(const LAS f4*)(R + ra), be = *(const LAS f4*)(R + rb);
#pragma unroll
                for (int e = 0; e < 4; ++e) {
#pragma unroll
                    for (int m = 0; m < 4; ++m) {
                        const float c_ = acc[ai][0][m][n][e];
                        const float tp = (m == 0) ? ab[e] : DPPZ(acc[ai][0][m - 1][n][e], 0x10F);
                        const float tn = (m == 3) ? be[e] : DPPZ(acc[ai][0][m + 1][n][e], 0x11F);
                        const float pv_ = DPPF(tp, c_, 0x111), nx_ = DPPF(tn, c_, 0x101);
                        acc[ai][1][m][n][e] = w0[e] * pv_ + w1[e] * c_ + w2[e] * nx_ + bb[e];
                    }
                    __builtin_amdgcn_sched_barrier(0);
                }
            }
        }
#pragma unroll
        for (int ai = 0; ai < 2; ++ai)
#pragma unroll
            for (int m = 0; m < 4; ++m) { bf16_t* p = O + (size_t)(u.pm * 256 + ai * 128 + wr * 64 + m * 16 + fr) * INW + 1280 + 128 * jt + cl;
                const f4 v0 = acc[ai][1][m][0], v1 = acc[ai][1][m][1];
                u32x4 w; w.x = pk(v0[0], v0[1]); w.y = pk(v0[2], v0[3]); w.z = pk(v1[0], v1[1]); w.w = pk(v1[2], v1[3]);
                *(u32x4*)p = w; }
    }
    __device__ __forceinline__ void operator()(pg8::f32x4 (&acc)[2][2][4][2], const pg8::Unit& u, int wr, int wc, int fr, int fq) const {
        typedef pg8::f32x4 f4;
        if (u.pm != last_pm) { row_stats_to_lds(SP, u.pm, T, (wr * 4 + wc) * 64 + fq * 16 + fr); last_pm = u.pm; }
        const int cb = u.pn * 256 + wc * 32 + 8 * fq;
        f4 cv[2][2], dv[2][2];
#pragma unroll
        for (int bj = 0; bj < 2; ++bj)
#pragma unroll
            for (int n = 0; n < 2; ++n) { cv[bj][n] = *(const f4*)(cvec + cb + 128 * bj + 4 * n); dv[bj][n] = *(const f4*)(dvec + cb + 128 * bj + 4 * n); }
#pragma unroll
        for (int ai = 0; ai < 2; ++ai)
#pragma unroll
            for (int m = 0; m < 4; ++m) { const int rl = ai * 128 + wr * 64 + m * 16 + fr; const f2v st = T[rl]; const float r = st.y, rm = -st.x * st.y;
#pragma unroll
                for (int bj = 0; bj < 2; ++bj) { acc[ai][bj][m][0] = acc[ai][bj][m][0] * r + (cv[bj][0] * rm + dv[bj][0]); acc[ai][bj][m][1] = acc[ai][bj][m][1] * r + (cv[bj][1] * rm + dv[bj][1]); } }
        if (u.pn >= 5) { conv_tile(acc, u, wr, wc, fr, fq); return; }
        if (u.pn == 2) {
            float part[2][4];
            asm volatile("" : "+v"(fr), "+v"(fq));
#pragma unroll
            for (int ai = 0; ai < 2; ++ai)
#pragma unroll
                for (int m = 0; m < 4; ++m) { const f4 a0 = acc[ai][0][m][0], a1 = acc[ai][0][m][1];
                    float ss = ((a0[0] * a0[0] + a0[1] * a0[1]) + (a0[2] * a0[2] + a0[3] * a0[3])) + ((a1[0] * a1[0] + a1[1] * a1[1]) + (a1[2] * a1[2] + a1[3] * a1[3]));
                    ss += swz_xor<16>(ss); { auto rr = __builtin_amdgcn_permlane32_swap(__float_as_uint(ss), __float_as_uint(ss), false, false); ss = __uint_as_float(rr[0]) + __uint_as_float(rr[1]); }
                    part[ai][m] = ss; if (fq == 0) R[(ai * 128 + wr * 64 + m * 16 + fr) * 4 + wc] = ss; }
            asm volatile("s_waitcnt lgkmcnt(0)" ::: "memory"); __builtin_amdgcn_s_barrier(); asm volatile("" ::: "memory");
            const int dim0 = (wc & 1) * 32 + 8 * fq;
            const f4 g0 = *(const f4*)(kn + dim0), g1 = *(const f4*)(kn + dim0 + 4);
#pragma unroll
            for (int ai = 0; ai < 2; ++ai)
#pragma unroll
                for (int m = 0; m < 4; ++m) { const int rl = ai * 128 + wr * 64 + m * 16 + fr;
                    const float tot = part[ai][m] + R[rl * 4 + (wc ^ 1)], rn = 1.f / sqrtf(tot * (1.f / 64.f) + LN_EPS);
                    int t, S; tokpos(u.pm * 256 + rl, t, S);
                    const float* rp = rope + ((size_t)t * 32 + (dim0 >> 1)) * 2;
                    const f4 c01 = *(const f4*)rp, c23 = *(const f4*)(rp + 4);
                    const f4 a0 = acc[ai][0][m][0] * rn * g0, a1 = acc[ai][0][m][1] * rn * g1;
                    acc[ai][0][m][0] = (f4){a0[0] * c01[0] - a0[1] * c01[1], a0[0] * c01[1] + a0[1] * c01[0], a0[2] * c01[2] - a0[3] * c01[3], a0[2] * c01[3] + a0[3] * c01[2]};
                    acc[ai][0][m][1] = (f4){a1[0] * c23[0] - a1[1] * c23[1], a1[0] * c23[1] + a1[1] * c23[0], a1[2] * c23[2] - a1[3] * c23[3], a1[2] * c23[3] + a1[3] * c23[2]};
                    asm volatile("" ::: "memory"); __builtin_amdgcn_sched_barrier(0); }
            store_tile(acc, u, wr, wc, fr, fq); return;
        }
        store_tile(acc, u, wr, wc, fr, fq);
    }
};
struct EpiResLn {
    static constexpr bool PERM = true, AFTER_DRAIN = false;
    float* X; bf16_t* XB; const float* SPin; float* SPout; const float* g; const float* b; LAS f2v* T; float alpha;
    __device__ __forceinline__ void operator()(pg8::f32x4 (&acc)[2][2][4][2], const pg8::Unit& u, int wr, int wc, int fr, int fq) const {
        typedef pg8::f32x4 f4;
        row_stats_to_lds(SPin, u.pm, T, (wr * 4 + wc) * 64 + fq * 16 + fr);
        const int cb = u.pn * 256 + wc * 32 + 8 * fq;
        f4 gv[2][2], bv[2][2];
#pragma unroll
        for (int bj = 0; bj < 2; ++bj)
#pragma unroll
            for (int n = 0; n < 2; ++n) { gv[bj][n] = *(const f4*)(g + cb + 128 * bj + 4 * n); bv[bj][n] = *(const f4*)(b + cb + 128 * bj + 4 * n); }
#pragma unroll
        for (int ai = 0; ai < 2; ++ai)
#pragma unroll
            for (int m = 0; m < 4; ++m) { const int rl = ai * 128 + wr * 64 + m * 16 + fr; const f2v st = T[rl]; const float r = st.y, rm = -st.x * st.y;
                const size_t off = (size_t)(u.pm * 256 + rl) * DM + cb; float s1 = 0.f, s2 = 0.f;
#pragma unroll
                for (int bj = 0; bj < 2; ++bj) { f4 pre[2]; float xin[8]; unpack8h(*(const u32x4*)(XB + off + 128 * bj), xin);
#pragma unroll
                    for (int n = 0; n < 2; ++n) { const f4 v = {xin[4 * n], xin[4 * n + 1], xin[4 * n + 2], xin[4 * n + 3]}; const f4 xr = (v * r + rm) * gv[bj][n] + bv[bj][n];
                        pre[n] = xr * alpha + acc[ai][bj][m][n]; if (X) *(f4*)(X + off + 128 * bj + 4 * n) = pre[n];
                        s1 += (pre[n][0] + pre[n][1]) + (pre[n][2] + pre[n][3]); s2 += (pre[n][0] * pre[n][0] + pre[n][1] * pre[n][1]) + (pre[n][2] * pre[n][2] + pre[n][3] * pre[n][3]); }
                    u32x4 w; w.x = pkh(pre[0][0], pre[0][1]); w.y = pkh(pre[0][2], pre[0][3]); w.z = pkh(pre[1][0], pre[1][1]); w.w = pkh(pre[1][2], pre[1][3]);
                    if (!X) *(u32x4*)(XB + off + 128 * bj) = w; }
                s1 += swz_xor<16>(s1); s2 += swz_xor<16>(s2);
                { auto r1 = __builtin_amdgcn_permlane32_swap(__float_as_uint(s1), __float_as_uint(s1), false, false); s1 = __uint_as_float(r1[0]) + __uint_as_float(r1[1]);
                  auto r2 = __builtin_amdgcn_permlane32_swap(__float_as_uint(s2), __float_as_uint(s2), false, false); s2 = __uint_as_float(r2[0]) + __uint_as_float(r2[1]); }
                if (fq == 0) *(f2v*)(SPout + (size_t)(u.pm * 256 + rl) * 32 + (u.pn * 4 + wc) * 2) = (f2v){s1, s2};
            }
    }
};

#define XB_TMO      128
#define XB_XCNT(j)  (256  + 64 * (j))
#define XB_XSUB(j)  (1280 + 64 * (j))
#define XB_XGEN(j)  (2304 + 64 * (j))
#define XB_TOP      3328
#define XB_TOPGEN   3392
#define XCD_BAR_WORDS 3456
#define XB_SPIN_CAP (1u << 18)

__device__ __forceinline__ unsigned xb_ld(unsigned* p)              { return __hip_atomic_load(p, __ATOMIC_RELAXED, __HIP_MEMORY_SCOPE_AGENT); }
__device__ __forceinline__ unsigned xb_add(unsigned* p, unsigned v) { return __hip_atomic_fetch_add(p, v, __ATOMIC_RELAXED, __HIP_MEMORY_SCOPE_AGENT); }
__device__ __forceinline__ unsigned xb_xcc_id() { return (unsigned)__builtin_amdgcn_s_getreg((3 << 11) | 20) & 0xFu; }
#define XB_SPIN(cond, bar) do { unsigned _sp = 0; while (cond) { __builtin_amdgcn_s_sleep(1); \
    if ((++_sp & 255u) == 0u) { if (xb_ld(&(bar)[XB_TMO])) break; if (_sp > XB_SPIN_CAP) { atomicAdd(&(bar)[XB_TMO], 1u); break; } } } } while (0)

struct XcdBarrier {
    unsigned* bar; unsigned x;
    volatile LAS unsigned* st;
};

__device__ __forceinline__ XcdBarrier xcd_barrier_post(unsigned* bar, volatile LAS unsigned* st) {
    XcdBarrier b; b.bar = bar; b.x = xb_xcc_id(); b.st = st;
    if (threadIdx.x == 0) (void)xb_add(&bar[XB_XCNT(b.x)], 1u);
    return b;
}
__device__ __forceinline__ void xcd_barrier_complete(unsigned* bar, unsigned x, unsigned& nloc, unsigned& nx) {
    const unsigned G = gridDim.x * gridDim.y * gridDim.z;
    unsigned sum, cnt, mine, sp = 0u;
    for (;;) {
        sum = 0u; cnt = 0u; mine = 0u;
#pragma unroll
        for (unsigned j = 0; j < 16; ++j) { const unsigned c = xb_ld(&bar[XB_XCNT(j)]); sum += c; cnt += (c > 0u) ? 1u : 0u; mine = (j == x) ? c : mine; }
        if (sum == G) break;
        __builtin_amdgcn_s_sleep(1);
        if ((++sp & 255u) == 0u) { if (xb_ld(&bar[XB_TMO])) break; if (sp > XB_SPIN_CAP) { atomicAdd(&bar[XB_TMO], 1u); break; } }
    }
    nloc = mine > 0u ? mine : 1u; nx = cnt > 0u ? cnt : 1u;
}

__device__ __forceinline__ void xcd_barrier(const XcdBarrier& b) {
    asm volatile("s_waitcnt vmcnt(0)" ::: "memory");
    __syncthreads();
    if (threadIdx.x == 0) {
        unsigned* bar = b.bar;
        __builtin_amdgcn_s_waitcnt(0);
        unsigned nloc = b.st[0], nx = b.st[1];
        if (nloc == 0u) { xcd_barrier_complete(bar, b.x, nloc, nx); b.st[0] = nloc; b.st[1] = nx; }
        const unsigned old = xb_add(&bar[XB_XSUB(b.x)], 1u);
        const unsigned gen = old / nloc;
        if (old + 1u == (gen + 1u) * nloc) {
            __builtin_amdgcn_fence(__ATOMIC_RELEASE, "agent");
            asm volatile("s_waitcnt vmcnt(0)" ::: "memory");
            const unsigned og = xb_add(&bar[XB_TOP], 1u);
            const unsigned tg = og / nx;
            if (og + 1u == (tg + 1u) * nx) xb_add(&bar[XB_TOPGEN], 1u);
            else XB_SPIN(xb_ld(&bar[XB_TOPGEN]) == tg, bar);
            __builtin_amdgcn_fence(__ATOMIC_ACQUIRE, "agent");
            xb_add(&bar[XB_XGEN(b.x)], 1u);
            asm volatile("s_waitcnt vmcnt(0)" ::: "memory");
        } else {
            XB_SPIN(xb_ld(&bar[XB_XGEN(b.x)]) == gen, bar);
            __builtin_amdgcn_fence(__ATOMIC_ACQUIRE, "agent");
            asm volatile("s_waitcnt vmcnt(0)" ::: "memory");
        }
    }
    __syncthreads();
}

struct Args { const float* in[16]; float* out; unsigned char* ws; };

#define ENV() \
    const __attribute__((address_space(4))) Args* ap = kp; asm volatile("" : "+s"(ap)); \
    int tid = threadIdx.x; asm volatile("" : "+v"(tid)); \
    const int lane = tid & 63, wave = __builtin_amdgcn_readfirstlane(tid >> 6); \
    const int G = gridDim.x, bx = blockIdx.x; \
    const int vcu = (G % 8 == 0) ? (bx % 8) * (G / 8) + bx / 8 : bx; \
    const int gw = vcu * 8 + wave, NGW = G * 8; \
    const size_t gtid = (size_t)bx * 512 + tid, gsz = (size_t)G * 512; \
    unsigned char* ws = ap->ws; float* X = ap->out; \
    bf16_t* XBF = (bf16_t*)(ws + WS_XBF); bf16_t* Z = (bf16_t*)(ws + WS_Z); bf16_t* MIX = (bf16_t*)(ws + WS_MIX); \
    bf16_t* H = (bf16_t*)(ws + WS_H); float* EDGE = (float*)(ws + WS_EDGE); float2* ROPE = (float2*)(ws + WS_ROPE); \
    float* SPA = (float*)(ws + WS_SPA); float* SPB = (float*)(ws + WS_SPB); float* CDIN = (float*)(ws + WS_CDIN); float* CDUP = (float*)(ws + WS_CDUP); \
    float2* PIN = (float2*)(ws + WS_PIN); float2* PUP = (float2*)(ws + WS_PUP); float* ONES = (float*)(ws + WS_ONES); float* EDGE2 = (float*)(ws + WS_EDGE2); (void)EDGE2; LAS f2v* TST = (LAS f2v*)((LAS unsigned char*)lds + ST_OFF); \
    (void)SPA; (void)SPB; (void)CDIN; (void)CDUP; (void)PIN; (void)PUP; (void)ONES; (void)TST; \
    (void)lane; (void)wave; (void)gw; (void)NGW; (void)gtid; (void)gsz; (void)X; (void)XBF; (void)Z; (void)MIX; (void)EDGE; (void)H; (void)ROPE;

__global__ void __launch_bounds__(512, 2) mega_fwd(Args a_unused) {
    extern __shared__ __attribute__((aligned(16))) unsigned char lds[];
    cg::grid_group grid = cg::this_grid();
    const __attribute__((address_space(4))) Args* kp = (const __attribute__((address_space(4))) Args*)__builtin_amdgcn_kernarg_segment_ptr();

    if (threadIdx.x < 2) ((volatile LAS unsigned*)((LAS unsigned char*)lds + BARST_OFF))[threadIdx.x] = 0u;
    __syncthreads();
    {
        ENV();
        if (bx == 0) for (int i = tid; i < XCD_BAR_WORDS; i += 512) ((unsigned*)(ws + WS_BAR))[i] = 0u;
        LAS float* scr = (LAS float*)((LAS unsigned char*)lds + wave * 16384);
        constexpr int I_IN = 16 * 72, I_O = 16 * 32, I_UP = 16 * 176, I_DN = 44 * 32, I_L = I_IN + I_O + I_UP + I_DN;
        for (int it = gw; it < NLAYER * I_L; it += NGW) {
            const int l = it / I_L; int r = it % I_L; unsigned char* wl = ws + WS_W + (size_t)l * W_LAYER;
            if (r < I_IN) { const bool f = l > 0;
                transpose_item(ap->in[2] + (size_t)l * DM * INW, DM, INW, (bf16_t*)(wl + W_IN), 1280, 512, f ? ap->in[14] + (l - 1) * DM : nullptr, f ? ap->in[15] + (l - 1) * DM : nullptr,
                               f ? PIN + (size_t)l * 16 * INW : nullptr, scr, r, lane, true); continue; } r -= I_IN;
            if (r < I_O) { transpose_item(ap->in[7] + (size_t)l * DM * DM, DM, DM, (bf16_t*)(wl + W_O), 0, 0, nullptr, nullptr, nullptr, scr, r, lane); continue; } r -= I_O;
            if (r < I_UP) { transpose_item(ap->in[10] + (size_t)l * DM * UPW, DM, UPW, (bf16_t*)(wl + W_UP), 0, DFF, ap->in[8] + l * DM, ap->in[9] + l * DM, PUP + (size_t)l * 16 * UPW, scr, r, lane, true); continue; } r -= I_UP;
            transpose_item(ap->in[13] + (size_t)l * DFF * DM, DFF, DM, (bf16_t*)(wl + W_DOWN), 0, 0, nullptr, nullptr, nullptr, scr, r, lane);
        }
        for (size_t i = gtid; i < (size_t)MTOK * 8; i += gsz) ((f32x4*)SPB)[i] = (i & 7) == 0 ? (f32x4){0.f, (float)DM * (1.f - LN_EPS), 0.f, 0.f} : (f32x4){0.f, 0.f, 0.f, 0.f};
        for (size_t i = gtid; i < 2048; i += gsz) ONES[i] = i < 1024 ? 1.f : 0.f;
        for (size_t i = gtid; i < 2 * INW; i += gsz) CDIN[i] = 0.f;
        for (size_t i = gtid; i < 8192 * 32; i += gsz) {
            const int t = (int)(i >> 5), p = (int)(i & 31); const int pos = p < 16 ? (t >> 6) : (t & 63);
            const float angf = (float)pos * __builtin_amdgcn_exp2f(-(float)(p & 15) * 0.83048202372184059f);
            double r = (double)angf; r -= 6.283185307179586476925 * __builtin_rint(r * 0.15915494309189533577);
            const double r2 = r * r; double sn, cs;
            sn = -1.0 / 51090942171709440000.0; cs = 1.0 / 2432902008176640000.0;
            sn = sn * r2 + 1.0 / 121645100408832000.0; cs = cs * r2 - 1.0 / 6402373705728000.0;
            sn = sn * r2 - 1.0 / 355687428096000.0;    cs = cs * r2 + 1.0 / 20922789888000.0;
            sn = sn * r2 + 1.0 / 1307674368000.0;      cs = cs * r2 - 1.0 / 87178291200.0;
            sn = sn * r2 - 1.0 / 6227020800.0;         cs = cs * r2 + 1.0 / 479001600.0;
            sn = sn * r2 + 1.0 / 39916800.0;           cs = cs * r2 - 1.0 / 3628800.0;
            sn = sn * r2 - 1.0 / 362880.0;             cs = cs * r2 + 1.0 / 40320.0;
            sn = sn * r2 + 1.0 / 5040.0;               cs = cs * r2 - 1.0 / 720.0;
            sn = sn * r2 - 1.0 / 120.0;                cs = cs * r2 + 1.0 / 24.0;
            sn = sn * r2 + 1.0 / 6.0;                  cs = cs * r2 - 1.0 / 2.0;
            sn = sn * r2 - 1.0; sn = -sn * r;          cs = cs * r2 + 1.0;
            ROPE[i] = make_float2((float)cs, (float)sn);
        }
        for (int m = gw; m < MTOK; m += NGW) {
            const float* src = m < MHALF ? ap->in[0] + (size_t)m * DM : ap->in[1] + (size_t)(m - MHALF) * DM;
            row_pass<false, false>(src, nullptr, XBF + (size_t)m * DM, nullptr, nullptr, lane);
        }
    }
    grid.sync();
    const XcdBarrier xbar = xcd_barrier_post((unsigned*)(kp->ws + WS_BAR), (volatile LAS unsigned*)((LAS unsigned char*)lds + BARST_OFF));

#pragma nounroll
    for (int l = 0; l < NLAYER; ++l) {
        {
            ENV(); unsigned char* wl = ws + WS_W + (size_t)l * W_LAYER;
            pg8::Gemm g{XBF, (const bf16_t*)(wl + W_IN), MTOK, INW, DM}; pg8::StaticOrder S; S.init(MTOK, INW, G, bx);
            EpiZ E{Z, SPB, CDIN + (size_t)l * 2 * INW, CDIN + (size_t)l * 2 * INW + INW, TST, EDGE2, ap->in[5] + l * 3 * 512, ap->in[6] + l * 512, (LAS float*)((LAS unsigned char*)lds + HALO_OFF), (const float*)ROPE, ap->in[4] + l * 64, -1};
            pg8::gemm_phase<EpiZ, pg8::StaticOrder, true, true, true>((LAS unsigned char*)lds, g, S, E);
        }
        xcd_barrier(xbar);
        {
            ENV();
            if (l == 0) {
                for (size_t i = gtid; i < (size_t)3 * INW + 4 * UPW; i += gsz) {
                    const bool up = i >= (size_t)3 * INW; const int N = up ? UPW : INW; const int r = up ? (int)(i - 3 * INW) : (int)i + INW, ll = r / N, n = r % N;
                    const float2* P = (up ? PUP : PIN) + (size_t)ll * 16 * N + n; float cs = 0.f, ds = 0.f;
#pragma unroll
                    for (int kb = 0; kb < 16; ++kb) { const float2 v = P[(size_t)kb * N]; cs += v.x; ds += v.y; }
                    float* CD = (up ? CDUP : CDIN) + (size_t)ll * 2 * N; CD[n] = cs; CD[N + n] = ds;
                }
            }
            const int xcd = vcu >> 5, jc = vcu & 31;
#pragma nounroll
            for (int i = 0; i < 8; ++i) {
                long rowbase; int NT, qb, h, kvh;
                if (i < 4) { const int ui = jc * 4 + i; kvh = xcd & 1; h = kvh * 4 + (ui >> 5); qb = ui & 31; rowbase = MHALF + (long)(xcd >> 1) * 8192; NT = 128; }
                else { const int ui = jc * 4 + (i - 4), pair = 2 * xcd + (ui >> 6), r = ui & 63; kvh = pair & 1; h = kvh * 4 + (r >> 4); qb = r & 15; rowbase = (long)(pair >> 1) * 4096; NT = 64; }
                attn_body::attn_unit<8>(rowbase, NT, qb * 256, (const attn_body::bf16*)(Z + h * 64), (const attn_body::bf16*)(Z + 512 + kvh * 64), (const attn_body::bf16*)(Z + 640 + kvh * 64),
                                        (attn_body::bf16*)(MIX + h * 64), (char*)lds, (const float*)ROPE, ap->in[3] + l * 64);
                conv_mix_unit(Z, MIX, EDGE2, ap->in[5] + l * 3 * 512, ap->in[6] + l * 512, rowbase + qb * 256, h, qb * 256, NT * 64, tid);
            }
        }
        xcd_barrier(xbar);
        {
            ENV(); unsigned char* wl = ws + WS_W + (size_t)l * W_LAYER;
            pg8::Gemm g{MIX, (const bf16_t*)(wl + W_O), MTOK, DM, DM}; pg8::StaticOrder S; S.init(MTOK, DM, G, bx);
            EpiResLn E{nullptr, XBF, SPB, SPA, l > 0 ? ap->in[14] + (l - 1) * DM : ONES, l > 0 ? ap->in[15] + (l - 1) * DM : ONES + 1024, TST, ALPHA};
            pg8::gemm_phase<EpiResLn, pg8::StaticOrder, true, true>((LAS unsigned char*)lds, g, S, E);
        }
        xcd_barrier(xbar);
        {
            ENV(); unsigned char* wl = ws + WS_W + (size_t)l * W_LAYER;
            pg8::Gemm g{XBF, (const bf16_t*)(wl + W_UP), MTOK, UPW, DM}; pg8::StaticOrder S; S.init(MTOK, UPW, G, bx);
            EpiFfn E{H, EDGE, ap->in[11] + (size_t)l * 3 * UPW, ap->in[12] + (size_t)l * UPW, (LAS float*)((LAS unsigned char*)lds + HALO_OFF), SPA, CDUP + (size_t)l * 2 * UPW, CDUP + (size_t)l * 2 * UPW + UPW, TST, -1};
            pg8::gemm_phase<EpiFfn, pg8::StaticOrder, true, true, true>((LAS unsigned char*)lds, g, S, E);
        }
        xcd_barrier(xbar);
        {
            ENV();
            const float* fw = ap->in[11] + (size_t)l * 3 * UPW; const float* fb = ap->in[12] + (size_t)l * UPW;
            for (size_t it = gtid; it < (size_t)512 * 352; it += gsz) { const int rr = (int)(it / 352), ch = (int)(it % 352); ffn_fix_item(EDGE, H, rr >> 1, rr & 1, ch, fw, fb); }
        }
        xcd_barrier(xbar);
        {
            ENV(); unsigned char* wl = ws + WS_W + (size_t)l * W_LAYER;
            pg8::Gemm g{H, (const bf16_t*)(wl + W_DOWN), MTOK, DM, DFF}; pg8::StaticOrder S; S.init(MTOK, DM, G, bx);
            EpiResLn E{l == NLAYER - 1 ? X : nullptr, XBF, SPA, SPB, ap->in[8] + l * DM, ap->in[9] + l * DM, TST, ALPHA};
            pg8::gemm_phase<EpiResLn, pg8::StaticOrder, true, true>((LAS unsigned char*)lds, g, S, E);
        }
        xcd_barrier(xbar);
    }
    {
        ENV();
        for (int m = gw; m < MTOK; m += NGW) row_pass<true, true, false>(X + (size_t)m * DM, X + (size_t)m * DM, nullptr, ap->in[14] + (NLAYER - 1) * DM, ap->in[15] + (NLAYER - 1) * DM, lane);
    }
}
}

extern "C" void kernel_launch(void* const* d_in, const int* in_sizes, int n_in, void* d_out, int out_size, void* d_ws, size_t ws_size, hipStream_t stream) {
    static int grid = 0;
    if (grid == 0) {
        if (n_in != 16 || out_size != mk::MTOK * mk::DM || ws_size < mk::WS_END) { fprintf(stderr, "kernel_launch: unexpected shapes (n_in %d out %d ws %zu)\n", n_in, out_size, ws_size); grid = -1; return; }
        int dev = 0, cus = 0, per_cu = 0;
        (void)hipGetDevice(&dev);
        (void)hipDeviceGetAttribute(&cus, hipDeviceAttributeMultiprocessorCount, dev);
        (void)hipFuncSetAttribute((const void*)mk::mega_fwd, hipFuncAttributeMaxDynamicSharedMemorySize, mk::LDS_BYTES);
        (void)hipOccupancyMaxActiveBlocksPerMultiprocessor(&per_cu, (const void*)mk::mega_fwd, 512, mk::LDS_BYTES);
        (void)hipGetLastError();
        grid = cus;
        fprintf(stderr, "kernel_launch: cus %d per_cu %d grid %d\n", cus, per_cu, grid);
    }
    if (grid < 0) return;
    mk::Args a{};
    for (int i = 0; i < 16; ++i) a.in[i] = (const float*)d_in[i];
    a.out = (float*)d_out; a.ws = (unsigned char*)d_ws;
    void* args[] = {&a};
    hipError_t e = hipLaunchCooperativeKernel((const void*)mk::mega_fwd, dim3(grid), dim3(512), args, mk::LDS_BYTES, stream);
    if (e != hipSuccess) fprintf(stderr, "cooperative launch failed: %s (grid %d)\n", hipGetErrorString(e), grid);
}
```

```cpp
#include <hip/hip_runtime.h>
#include <hip/hip_cooperative_groups.h>
#include <cstdio>
#include <cstdint>
#include <cmath>
namespace cg = cooperative_groups;

namespace pg8 {

#define PG8_LAS __attribute__((address_space(3)))
typedef unsigned short bf16_t;
typedef short bf16x8 __attribute__((ext_vector_type(8)));
typedef float f32x4 __attribute__((ext_vector_type(4)));
typedef unsigned u32x4 __attribute__((ext_vector_type(4)));
constexpr int BM = 256, BK = 64, HALF = 128, HTB = HALF * BK * 2  , STAGE_BYTES = 8 * HTB, NXCD = 8, WGM = 8;

__host__ __device__ __forceinline__ int lds_byte(int r, int c) { const int st = (r >> 4) * 2 + (c >> 5), rr = r & 15, cc = c & 31, ob = rr * 64 + cc * 2; return st * 1024 + (ob ^ (((ob >> 9) & 1) << 5)); }
__host__ __device__ __forceinline__ void stage_rc(int b, int& R, int& C) { const int st = b / 1024, sb = b % 1024, swz = sb ^ (((sb >> 9) & 1) << 5); R = (st >> 1) * 16 + swz / 64; C = (st & 1) * 32 + (swz % 64) / 2; }
__host__ __device__ __forceinline__ int perm32(int rho) { const int n = rho >> 4, i = rho & 15; return 8 * (i >> 2) + 4 * n + (i & 3); }

struct Unit { int pm, pn; };
struct Gemm { const bf16_t* A; const bf16_t* Bt; int M, N, K; };

struct StaticOrder {
    int nM, nN, nwg, G, c;
    __host__ __device__ void init(int M, int N, int G_, int c_) { nM = M / BM; nN = N / BM; nwg = nM * nN; G = G_; c = c_; }
    __host__ __device__ bool next(int i, Unit& u) const {
        const long L = (long)i * G + c; if (L >= nwg) return false;
        int wgid = (int)L; { const int q = nwg / NXCD, r = nwg % NXCD, xcd = wgid % NXCD, off = wgid / NXCD; wgid = (xcd < r ? xcd * (q + 1) : r * (q + 1) + (xcd - r) * q) + off; }
        const int nig = WGM * nN, gid = wgid / nig, fm = gid * WGM, gsz = (nM - fm) < WGM ? (nM - fm) : WGM;
        u.pm = fm + ((wgid % nig) % gsz); u.pn = (wgid % nig) / gsz; return true;
    }
    __device__ __forceinline__ void a_ready(const Unit&) const {}
    __device__ __forceinline__ void done(const Unit&) const {}
};

__device__ __forceinline__ unsigned cvt_pk_bf16(float lo, float hi) { unsigned r; asm volatile("v_cvt_pk_bf16_f32 %0, %1, %2" : "=v"(r) : "v"(lo), "v"(hi)); return r; }
typedef float f32x2 __attribute__((ext_vector_type(2)));
template <int ACT  > struct EpiBf16 {
    static constexpr bool PERM = true, AFTER_DRAIN = false; static_assert(ACT == 0, "EpiBf16: ACT is 0");
    bf16_t* O; int ldc; const float* bias; int split_cols; size_t split_stride; float scale0;
    __device__ __forceinline__ void operator()(const f32x4 (&acc)[2][2][4][2], const Unit& u, int wr, int wc, int fr, int fq) const {
        const int row0 = u.pm * BM + wr * 64 + fr; int colt = u.pn * BM; bf16_t* base = O;
        float sc = 1.f; if (split_cols) { const int t = colt / split_cols; base += (size_t)t * split_stride; colt -= t * split_cols; if (t == 0) sc = scale0; }
        const int col0 = colt + wc * 32 + 8 * fq, bcol0 = u.pn * BM + wc * 32 + 8 * fq;
        f32x4 bv[2][2];
#pragma unroll
        for (int bj = 0; bj < 2; ++bj)
#pragma unroll
            for (int n = 0; n < 2; ++n) bv[bj][n] = bias ? *(const f32x4*)(bias + bcol0 + bj * HALF + 4 * n) : (f32x4){0.f, 0.f, 0.f, 0.f};
#pragma unroll
        for (int ai = 0; ai < 2; ++ai)
#pragma unroll
            for (int m = 0; m < 4; ++m) { bf16_t* rowp = base + (size_t)(row0 + ai * HALF + m * 16) * ldc + col0;
#pragma unroll
                for (int bj = 0; bj < 2; ++bj) { f32x4 v0 = acc[ai][bj][m][0] + bv[bj][0], v1 = acc[ai][bj][m][1] + bv[bj][1];
                    v0 = v0 * sc; v1 = v1 * sc; u32x4 w; w.x = cvt_pk_bf16(v0[0], v0[1]); w.y = cvt_pk_bf16(v0[2], v0[3]); w.z = cvt_pk_bf16(v1[0], v1[1]); w.w = cvt_pk_bf16(v1[2], v1[3]);
                    *(u32x4*)(rowp + bj * HALF) = w; } }
    }
};
template <class Epi, class Sched, bool ALIGN_EPI = false, bool SP2 = false>
__device__ __forceinline__ void gemm_phase(PG8_LAS unsigned char* lds, const Gemm g, const Sched& S, const Epi& E) {
    int tid_l = threadIdx.x; asm volatile("" : "+v"(tid_l));
    const int tid = tid_l, wid = __builtin_amdgcn_readfirstlane(tid >> 6), lane = tid & 63, wr = wid >> 2, wc = wid & 3, fr = lane & 15, fq = lane >> 4;
    const int K = g.K, nt = K / BK;
    unsigned voffA[2], voffB[2];
#pragma unroll
    for (int i = 0; i < 2; ++i) { int R, C; stage_rc(tid * 16 + i * 8192, R, C); const int Rb = Epi::PERM ? ((R & ~31) + perm32(R & 31)) : R;
        voffA[i] = (unsigned)(R * K + C) * 2u; voffB[i] = (unsigned)(Rb * K + C) * 2u; }
    const size_t kstep = (size_t)(BK * 2);
    const size_t hstep = (size_t)HALF * K * 2;
    const size_t tstep = 2 * hstep;
    const unsigned ldsw = (unsigned)wid * 1024u;
    const int aoff = lds_byte(wr * 64 + fr, fq * 8), boff = lds_byte(wc * 32 + fr, fq * 8);
#define PG8_SA(b, h) (((b) * 2 + (h)) * HTB)
#define PG8_SB(b, h) ((4 + (b) * 2 + (h)) * HTB)
#define PG8_STAGE(bufoff, gbase, voff) do { _Pragma("unroll") for (int _i = 0; _i < 2; ++_i) \
        __builtin_amdgcn_global_load_lds((const unsigned*)((const char*)(gbase) + (voff)[_i]), (PG8_LAS unsigned*)(lds + (bufoff) + ldsw + _i * 8192), 16, 0, 0); } while (0)
#define PG8_LDA(dst, b, h) do { _Pragma("unroll") for (int m = 0; m < 4; ++m) _Pragma("unroll") for (int k = 0; k < 2; ++k) dst[m][k] = *(const PG8_LAS bf16x8*)(lds + PG8_SA(b, h) + aoff + m * 2048 + k * 1024); } while (0)
#define PG8_LDB(dst, b, h) do { _Pragma("unroll") for (int n = 0; n < 2; ++n) _Pragma("unroll") for (int k = 0; k < 2; ++k) dst[n][k] = *(const PG8_LAS bf16x8*)(lds + PG8_SB(b, h) + boff + n * 2048 + k * 1024); } while (0)
#define PG8_MMA(ai, bj, At, Bt) do { __builtin_amdgcn_s_setprio(1); _Pragma("unroll") for (int m = 0; m < 4; ++m) _Pragma("unroll") for (int n = 0; n < 2; ++n) _Pragma("unroll") for (int k = 0; k < 2; ++k) \
        acc[ai][bj][m][n] = __builtin_amdgcn_mfma_f32_16x16x32_bf16(Bt[n][k], At[m][k], acc[ai][bj][m][n], 0, 0, 0); __builtin_amdgcn_s_setprio(0); } while (0)
#define PG8_WAIT_V(n) asm volatile("s_waitcnt vmcnt(" #n ")" ::: "memory")
#define PG8_WAIT_L(n) asm volatile("s_waitcnt lgkmcnt(" #n ")" ::: "memory")
#define PG8_BAR __builtin_amdgcn_s_barrier()
#define PG8_SCHED __builtin_amdgcn_sched_barrier(0)
    Unit cur, nxt; int ui = 0;
    if (!S.next(0, cur)) return;
    f32x4 acc[2][2][4][2];
#pragma unroll
    for (int a = 0; a < 2; ++a)
#pragma unroll
        for (int b = 0; b < 2; ++b)
#pragma unroll
            for (int m = 0; m < 4; ++m)
#pragma unroll
                for (int n = 0; n < 2; ++n) acc[a][b][m][n] = (f32x4){0.f, 0.f, 0.f, 0.f};
    bf16x8 At[4][2], B0[2][2], B1[2][2];
    const char* cA = (const char*)g.A + (size_t)cur.pm * tstep; const char* cB = (const char*)g.Bt + (size_t)cur.pn * tstep;
    S.a_ready(cur);
    if constexpr (SP2) {
        PG8_STAGE(PG8_SB(0, 0), cB, voffB); PG8_STAGE(PG8_SB(0, 1), cB + hstep, voffB); PG8_STAGE(PG8_SA(0, 0), cA, voffA); PG8_STAGE(PG8_SA(0, 1), cA + hstep, voffA);
        if (wr == 1) PG8_BAR;
        PG8_WAIT_V(2); PG8_BAR;
        PG8_STAGE(PG8_SB(1, 0), cB + kstep, voffB); PG8_STAGE(PG8_SA(1, 0), cA + kstep, voffA); PG8_STAGE(PG8_SB(1, 1), cB + hstep + kstep, voffB);
        PG8_WAIT_V(6); PG8_BAR;
    } else {
        PG8_STAGE(PG8_SB(0, 0), cB, voffB); PG8_STAGE(PG8_SA(0, 0), cA, voffA); PG8_STAGE(PG8_SB(0, 1), cB + hstep, voffB); PG8_STAGE(PG8_SA(0, 1), cA + hstep, voffA);
        if (wr == 1) PG8_BAR;
        PG8_WAIT_V(4); PG8_BAR;
        PG8_STAGE(PG8_SB(1, 0), cB + kstep, voffB); PG8_STAGE(PG8_SA(1, 0), cA + kstep, voffA); PG8_STAGE(PG8_SB(1, 1), cB + hstep + kstep, voffB);
        PG8_WAIT_V(6); PG8_BAR;
    }
    for (;;) {
        const bool has_next = S.next(ui + 1, nxt);
        const char* nA = has_next ? (const char*)g.A + (size_t)nxt.pm * tstep : cA; const char* nB = has_next ? (const char*)g.Bt + (size_t)nxt.pn * tstep : cB;
        for (int t = 0; t < nt; t += 2) {
            const bool last = (t == nt - 2);
            const char* a1 = cA + (size_t)(t + 1) * kstep;
            const char* a2 = last ? nA : cA + (size_t)(t + 2) * kstep; const char* b2 = last ? nB : cB + (size_t)(t + 2) * kstep;
            const char* a3 = a2 + kstep; const char* b3 = b2 + kstep;
            if (last && has_next) S.a_ready(nxt);
            if constexpr (SP2) {
            PG8_LDB(B0, 0, 0); PG8_LDB(B1, 0, 1); PG8_SCHED; PG8_LDA(At, 0, 0); PG8_STAGE(PG8_SA(1, 1), a1 + hstep, voffA);
            PG8_WAIT_V(8); PG8_WAIT_L(0); PG8_BAR; PG8_MMA(0, 0, At, B0); PG8_MMA(0, 1, At, B1); PG8_BAR; PG8_SCHED;
            PG8_LDA(At, 0, 1); PG8_STAGE(PG8_SB(0, 0), b2, voffB); PG8_STAGE(PG8_SB(0, 1), b2 + hstep, voffB); PG8_STAGE(PG8_SA(0, 0), a2, voffA);
            PG8_WAIT_V(8); PG8_WAIT_L(0); PG8_BAR; PG8_MMA(1, 0, At, B0); PG8_MMA(1, 1, At, B1); PG8_BAR; PG8_SCHED;
            PG8_LDB(B0, 1, 0); PG8_LDB(B1, 1, 1); PG8_SCHED; PG8_LDA(At, 1, 0); PG8_STAGE(PG8_SA(0, 1), a2 + hstep, voffA);
            PG8_WAIT_V(8); PG8_WAIT_L(0); PG8_BAR; PG8_MMA(0, 0, At, B0); PG8_MMA(0, 1, At, B1); PG8_BAR; PG8_SCHED;
            PG8_LDA(At, 1, 1); PG8_STAGE(PG8_SB(1, 0), b3, voffB); PG8_STAGE(PG8_SB(1, 1), b3 + hstep, voffB); PG8_STAGE(PG8_SA(1, 0), a3, voffA);
            PG8_WAIT_V(8); PG8_WAIT_L(0); PG8_BAR; PG8_MMA(1, 0, At, B0); PG8_MMA(1, 1, At, B1); PG8_BAR; PG8_SCHED;
            } else {
            PG8_LDB(B0, 0, 0); PG8_SCHED; PG8_LDA(At, 0, 0); PG8_STAGE(PG8_SA(1, 1), a1 + hstep, voffA);
            PG8_WAIT_L(8); PG8_BAR; PG8_WAIT_L(0); PG8_MMA(0, 0, At, B0); PG8_BAR; PG8_SCHED;
            PG8_LDB(B1, 0, 1); PG8_STAGE(PG8_SB(0, 0), b2, voffB);
            PG8_BAR; PG8_WAIT_L(0); PG8_MMA(0, 1, At, B1); PG8_BAR;
            PG8_LDA(At, 0, 1); PG8_STAGE(PG8_SA(0, 0), a2, voffA);
            PG8_BAR; PG8_WAIT_L(0); PG8_MMA(1, 0, At, B0); PG8_BAR; PG8_SCHED;
            PG8_STAGE(PG8_SB(0, 1), b2 + hstep, voffB);
            PG8_WAIT_V(6); PG8_BAR; PG8_MMA(1, 1, At, B1); PG8_BAR;
            PG8_LDB(B0, 1, 0); PG8_SCHED; PG8_LDA(At, 1, 0); PG8_STAGE(PG8_SA(0, 1), a2 + hstep, voffA);
            PG8_WAIT_L(8); PG8_BAR; PG8_WAIT_L(0); PG8_MMA(0, 0, At, B0); PG8_BAR; PG8_SCHED;
            PG8_LDB(B1, 1, 1); PG8_STAGE(PG8_SB(1, 0), b3, voffB);
            PG8_BAR; PG8_WAIT_L(0); PG8_MMA(0, 1, At, B1); PG8_BAR;
            PG8_LDA(At, 1, 1); PG8_STAGE(PG8_SA(1, 0), a3, voffA);
            PG8_BAR; PG8_WAIT_L(0); PG8_MMA(1, 0, At, B0); PG8_BAR; PG8_SCHED;
            PG8_STAGE(PG8_SB(1, 1), b3 + hstep, voffB);
            PG8_WAIT_V(6); PG8_BAR; PG8_MMA(1, 1, At, B1); PG8_BAR;
            }
        }
        if constexpr (ALIGN_EPI) { if (wr == 0) PG8_BAR; }
        if constexpr (!Epi::AFTER_DRAIN) { E(acc, cur, wr, wc, fr, fq); S.done(cur); }
        if (!has_next) break;
#pragma unroll
        for (int a = 0; a < 2; ++a)
#pragma unroll
            for (int b = 0; b < 2; ++b)
#pragma unroll
                for (int m = 0; m < 4; ++m)
#pragma unroll
                    for (int n = 0; n < 2; ++n) acc[a][b][m][n] = (f32x4){0.f, 0.f, 0.f, 0.f};
        cur = nxt; cA = nA; cB = nB; ++ui;
        if constexpr (ALIGN_EPI) { if (wr == 1) PG8_BAR; }
    }
    PG8_WAIT_V(0);
    if constexpr (!ALIGN_EPI) { if (wr == 0) PG8_BAR; }
    PG8_BAR;
    if constexpr (Epi::AFTER_DRAIN) { E.fused(acc, cur, wr, wc, fr, fq, lds, wid, lane); S.done(cur); }
#undef PG8_SA
#undef PG8_SB
#undef PG8_STAGE
#undef PG8_LDA
#undef PG8_LDB
#undef PG8_MMA
#undef PG8_WAIT_V
#undef PG8_WAIT_L
#undef PG8_BAR
#undef PG8_SCHED
}
}
#include <hip/hip_bf16.h>
#include <cmath>
namespace attn_body {
using bf16=__hip_bfloat16;
using bf16x8=__attribute__((ext_vector_type(8)))short;
using s16x4=__attribute__((ext_vector_type(4)))short;
using f32x16=__attribute__((ext_vector_type(16)))float;
using u32x4=__attribute__((ext_vector_type(4)))unsigned;
using f32x4_t=__attribute__((ext_vector_type(4)))float;
constexpr int D=64,PQ=2304,PO=1024;
constexpr int NW=8,QBLK=32,QB=QBLK*NW,KVBLK=64;
__device__ __forceinline__ int crow(int r,int hi){return (r&3)+8*(r>>2)+4*hi;}
#define SBAR() __builtin_amdgcn_sched_barrier(0)
__device__ __forceinline__ void cmask(f32x16&p0,f32x16&p1,int jb,int qrel,int hi){
  const float NEG=-INFINITY; int kb=64*jb+4*hi;
  #pragma unroll
  for(int r=0;r<16;++r){int kv=kb+(r&3)+8*(r>>2); if(kv>qrel)p0[r]=NEG; if(kv+32>qrel)p1[r]=NEG;}
}

constexpr int NSLOT=3, SLOTB=8192;
constexpr int LDS_K=0, LDS_V=NSLOT*SLOTB, LDS_WS=2*NSLOT*SLOTB, LDS_OST=LDS_WS+NW*64*4, LDS_BYTES=LDS_OST+NW*4096;
constexpr float C2=0.125f*1.4426950408889634f;
__device__ __forceinline__ void glds16(const void*gsrc,unsigned lds_dst){unsigned keep;
  asm volatile("s_mov_b32 %0, m0\n\ts_mov_b32 m0, %2\n\ts_nop 0\n\tglobal_load_lds_dwordx4 %1, off\n\ts_mov_b32 m0, %0":"=&s"(keep):"v"(gsrc),"s"(lds_dst):"memory");}
__device__ __forceinline__ float max3f(float a,float b,float c){float r;asm("v_max3_f32 %0, %1, %2, %3":"=v"(r):"v"(a),"v"(b),"v"(c));return r;}
__device__ __forceinline__ float max2f(float a,float b){float r;asm("v_max_f32_e32 %0, %1, %2":"=v"(r):"v"(a),"v"(b));return r;}
__device__ __forceinline__ float fadd_s(float a,float b){float r;asm("v_add_f32_e32 %0, %1, %2":"=v"(r):"v"(a),"v"(b));return r;}
__device__ __forceinline__ float fsub_s(float a,float b){float r;asm("v_sub_f32_e32 %0, %1, %2":"=v"(r):"v"(a),"v"(b));return r;}
typedef float f32x2_t __attribute__((ext_vector_type(2))); typedef __bf16 bf16x2_t __attribute__((ext_vector_type(2)));
__device__ __forceinline__ unsigned cvtpk_s(float lo,float hi){f32x2_t v={lo,hi};bf16x2_t b=__builtin_convertvector(v,bf16x2_t);return __builtin_bit_cast(unsigned,b);}
#define WAIT_BAR(N) asm volatile("s_waitcnt vmcnt(" #N ") lgkmcnt(0)\n\ts_barrier":::"memory")

__device__ __forceinline__ void qkt(f32x16&p0,f32x16&p1,const char*Kslot,const bf16x8*qr,const f32x16&negm,int r32,int hi){
  const char*kb=Kslot+hi*1024+r32*16;
  #pragma unroll
  for(int d0=0;d0<4;++d0){
    const bf16x8 b0=*reinterpret_cast<const bf16x8*>(kb+d0*2048);
    const bf16x8 b1=*reinterpret_cast<const bf16x8*>(kb+d0*2048+512);
    if(d0==0){p0=__builtin_amdgcn_mfma_f32_32x32x16_bf16(b0,qr[0],negm,0,0,0);p1=__builtin_amdgcn_mfma_f32_32x32x16_bf16(b1,qr[0],negm,0,0,0);}
    else{p0=__builtin_amdgcn_mfma_f32_32x32x16_bf16(b0,qr[d0],p0,0,0,0);p1=__builtin_amdgcn_mfma_f32_32x32x16_bf16(b1,qr[d0],p1,0,0,0);}}
}
typedef __attribute__((address_space(3))) const char* lds_cptr;
typedef short v4i16_t __attribute__((ext_vector_type(4)));
__device__ __forceinline__ void kload8(bf16x8*kf,lds_cptr kp){
  kf[0]=*(const __attribute__((address_space(3))) bf16x8*)(kp);      kf[1]=*(const __attribute__((address_space(3))) bf16x8*)(kp+512);
  kf[2]=*(const __attribute__((address_space(3))) bf16x8*)(kp+2048); kf[3]=*(const __attribute__((address_space(3))) bf16x8*)(kp+2560);
  kf[4]=*(const __attribute__((address_space(3))) bf16x8*)(kp+4096); kf[5]=*(const __attribute__((address_space(3))) bf16x8*)(kp+4608);
  kf[6]=*(const __attribute__((address_space(3))) bf16x8*)(kp+6144); kf[7]=*(const __attribute__((address_space(3))) bf16x8*)(kp+6656);
}
__device__ __forceinline__ void kload2(bf16x8*kf,lds_cptr kp,int j){ kf[2*j]=*(const __attribute__((address_space(3))) bf16x8*)(kp+j*2048); kf[2*j+1]=*(const __attribute__((address_space(3))) bf16x8*)(kp+j*2048+512); }
__device__ __forceinline__ s16x4 vtr(lds_cptr p){ return __builtin_bit_cast(s16x4,__builtin_amdgcn_ds_read_tr16_b64_v4i16((__attribute__((address_space(3))) v4i16_t*)p)); }
__device__ __forceinline__ float rowmax(const f32x16&p0,const f32x16&p1){
  float a=max3f(p0[0],p0[1],p1[0]),b=max3f(p0[2],p0[3],p1[1]);a=max3f(a,p1[2],p1[3]);
  #pragma unroll
  for(int r=4;r<16;r+=4){a=max3f(a,p0[r],p0[r+1]);b=max3f(b,p0[r+2],p0[r+3]);a=max3f(a,p1[r],p1[r+1]);b=max3f(b,p1[r+2],p1[r+3]);}
  const float m=max2f(a,b);
  auto rr=__builtin_amdgcn_permlane32_swap(__float_as_uint(m),__float_as_uint(m),false,false);
  return max2f(__uint_as_float(rr[0]),__uint_as_float(rr[1]));
}
__device__ __forceinline__ void pv(f32x16*o,int vb,bf16x8 pa0,bf16x8 pa1,bf16x8 pa2,bf16x8 pa3){
  #pragma unroll
  for(int d0=0;d0<2;++d0){s16x4 lo[4],hi[4];
    #pragma unroll
    for(int ks=0;ks<4;++ks){
      asm volatile("ds_read_b64_tr_b16 %0,%1 offset:%c2":"=&v"(lo[ks]):"v"(vb),"i"(d0*4096+ks*1024):"memory");
      asm volatile("ds_read_b64_tr_b16 %0,%1 offset:%c2":"=&v"(hi[ks]):"v"(vb),"i"(d0*4096+ks*1024+512):"memory");}
    asm volatile("s_waitcnt lgkmcnt(0)":::"memory");SBAR();
    #define PK(k) (bf16x8){lo[k][0],lo[k][1],lo[k][2],lo[k][3],hi[k][0],hi[k][1],hi[k][2],hi[k][3]}
    o[d0]=__builtin_amdgcn_mfma_f32_32x32x16_bf16(pa0,PK(0),o[d0],0,0,0);
    o[d0]=__builtin_amdgcn_mfma_f32_32x32x16_bf16(pa1,PK(1),o[d0],0,0,0);
    o[d0]=__builtin_amdgcn_mfma_f32_32x32x16_bf16(pa2,PK(2),o[d0],0,0,0);
    o[d0]=__builtin_amdgcn_mfma_f32_32x32x16_bf16(pa3,PK(3),o[d0],0,0,0);
    #undef PK
  }
}

#ifndef ATTN_STORE16
#define ATTN_STORE16(p,v) (*(u32x4*)(p)=(v))
#endif
template<int THRL> __device__ __forceinline__ void attn_unit(long rowbase,int NT,int q0,const bf16*Qh,const bf16*Kc,const bf16*Vc,bf16*Oh,char*shm,const float*rope,const float*qn){
  int tid_l=threadIdx.x; asm volatile("":"+v"(tid_l)); const int tid=tid_l,lane=tid&63,r32=lane&31,hi=lane>>5; const int wid=__builtin_amdgcn_readfirstlane(tid>>6);
  const bf16*Qw=Qh+(rowbase+q0+wid*QBLK)*PQ;
  const bf16*Kh=Kc+rowbase*PQ,*Vh=Vc+rowbase*PQ;
  const unsigned lds0=(unsigned)(uintptr_t)shm;
  float*wsf=(float*)(shm+LDS_WS)+wid*64;
  const bf16*ksrc=Kh+(long)lane*PQ+wid*8;
  const bf16*vsrc=Vh+(long)(16*(wid&3)+(lane>>2))*PQ+(wid>>2)*32+(lane&3)*8;
  const unsigned kdst=lds0+LDS_K+wid*1024, vdst=lds0+LDS_V+wid*1024;
  #define DMA_K(t,slot) glds16(ksrc+(long)(t)*KVBLK*PQ,(unsigned)__builtin_amdgcn_readfirstlane(kdst+(slot)))
  #define DMA_V(t,slot) glds16(vsrc+(long)(t)*KVBLK*PQ,(unsigned)__builtin_amdgcn_readfirstlane(vdst+(slot)))
  const int vb0=(int)(lds0+LDS_V)+((lane>>4)&1)*32+(lane&3)*8+(4*hi+((lane&15)>>2))*64;
  const char*Kbase=shm+LDS_K; bf16x8 kf[8];
  const lds_cptr shm3=(lds_cptr)shm; const lds_cptr kp0=shm3+LDS_K+hi*1024+r32*16; const lds_cptr vp0=shm3+LDS_V+((lane>>4)&1)*32+(lane&3)*8+(4*hi+((lane&15)>>2))*64;
  DMA_K(0,0);DMA_V(0,0);DMA_K(1,SLOTB);
  bf16x8 qr[4];
  #pragma unroll
  for(int d0=0;d0<4;++d0)qr[d0]=*reinterpret_cast<const bf16x8*>(&Qw[(long)r32*PQ+d0*16+hi*8]);
  { float qf[4][8]; float ss=0.f;
    #pragma unroll
    for(int d0=0;d0<4;++d0){
      #pragma unroll
      for(int i=0;i<8;++i){ qf[d0][i]=__uint_as_float(((unsigned)(unsigned short)qr[d0][i])<<16); ss+=qf[d0][i]*qf[d0][i]; } }
    { auto rr=__builtin_amdgcn_permlane32_swap(__float_as_uint(ss),__float_as_uint(ss),false,false); ss=__uint_as_float(rr[0])+__uint_as_float(rr[1]); }
    const float rn=1.f/sqrtf(ss*(1.f/64.f)+1e-6f);
    const float*rp=rope+((long)(q0+wid*QBLK+r32)*32+hi*4)*2;
    #pragma unroll
    for(int d0=0;d0<4;++d0){
      const f32x4_t c01=*reinterpret_cast<const f32x4_t*>(rp+d0*16), c23=*reinterpret_cast<const f32x4_t*>(rp+d0*16+4);
      const f32x4_t g03=*reinterpret_cast<const f32x4_t*>(qn+d0*16+hi*8), g47=*reinterpret_cast<const f32x4_t*>(qn+d0*16+hi*8+4);
      const float cs_[4]={c01[0],c01[2],c23[0],c23[2]}, sn_[4]={c01[1],c01[3],c23[1],c23[3]}, gg[8]={g03[0],g03[1],g03[2],g03[3],g47[0],g47[1],g47[2],g47[3]};
      unsigned w[4];
      #pragma unroll
      for(int j=0;j<4;++j){ const float y0=qf[d0][2*j]*rn*gg[2*j], y1=qf[d0][2*j+1]*rn*gg[2*j+1];
        w[j]=cvtpk_s((y0*cs_[j]-y1*sn_[j])*C2,(y0*sn_[j]+y1*cs_[j])*C2); }
      qr[d0]=__builtin_bit_cast(bf16x8,(u32x4){w[0],w[1],w[2],w[3]}); } }
  float mhat=0.f,l_reg=0.f;f32x16 o[2];f32x16 negm;
  { float zz=0.f; asm volatile("":"+v"(zz));
    _Pragma("unroll") for(int r=0;r<16;++r){o[0][r]=zz;o[1][r]=zz;negm[r]=zz;} }
  asm volatile("":"+v"(negm));
  #define CMASK(P0,P1,t) do{}while(0)
  bool resc=false;
  #define START(P0,P1) do{ const float rm=rowmax(P0,P1); resc=false; \
    { const float dl=rm; mhat=fadd_s(mhat,dl); \
      _Pragma("unroll") for(int r=0;r<16;++r){P0[r]=fsub_s(P0[r],dl);P1[r]=fsub_s(P1[r],dl);} \
      _Pragma("unroll") for(int r=0;r<16;++r)negm[r]=-mhat; asm volatile("":"+v"(negm)); } \
    _Pragma("unroll") for(int r=0;r<16;++r)P0[r]=__builtin_amdgcn_exp2f(P0[r]); }while(0)
  #define RESC() do{ if(resc){ asm volatile("s_waitcnt lgkmcnt(0)":::"memory"); \
      _Pragma("unroll") for(int d_=0;d_<2;++d_) _Pragma("unroll") for(int r=0;r<16;++r)o[d_][r]*=wsf[crow(r,hi)]; } }while(0)
  f32x16 pA0,pA1,pB0,pB1;
  int sl_prev=0,sl_cur=0,sl_next=SLOTB;
  #define ROT() do{sl_prev=sl_cur;sl_cur=sl_next;sl_next=(sl_next==(NSLOT-1)*SLOTB)?0:sl_next+SLOTB;}while(0)
  DMA_K(2,2*SLOTB);
  WAIT_BAR(3);
  qkt(pA0,pA1,Kbase,qr,negm,r32,hi);asm volatile("s_nop 15\n\ts_nop 7":"+v"(pA0),"+v"(pA1));CMASK(pA0,pA1,0);
  START(pA0,pA1);
  _Pragma("unroll") for(int r=0;r<16;++r)pA1[r]=__builtin_amdgcn_exp2f(pA1[r]);
  WAIT_BAR(0);
  DMA_K(3,0);DMA_V(1,SLOTB);
  ROT();
  kload8(kf,kp0+sl_cur);
  WAIT_BAR(2);
  s16x4 vlo[8],vhi[8]; u32x4 pw0,pw1,pw2,pw3;
  #define PKW(P,B) cvtpk_s(P[B],P[B+1])
  #define PAF(k) __builtin_bit_cast(bf16x8,pw##k)
  #define VFR(i) (bf16x8){vlo[i][0],vlo[i][1],vlo[i][2],vlo[i][3],vhi[i][0],vhi[i][1],vhi[i][2],vhi[i][3]}
  #define PIN(x) asm volatile("":"+v"(x))
  #define MX3(a,b,c) __builtin_fmaxf(__builtin_fmaxf((a),(b)),(c))
  #define GAPA(MF,A0,A1,A2,A3,W0,W1,PW) do{ MF; sacc+=A0; sacc+=A1; sacc+=A2; sacc+=A3; PIN(sacc); W0; W1; PIN(PW); SBAR(); }while(0)
  #define EX(v) __builtin_amdgcn_exp2f(v)
  #define GAPB(MF,X,B) do{ MF; X[B]=EX(X[B]); X[B+1]=EX(X[B+1]); X[B+2]=EX(X[B+2]); X[B+3]=EX(X[B+3]); PIN(X); SBAR(); }while(0)
  #define VRD(i) do{ vlo[i]=vtr(vp_+(((i)>>2)*4096+((i)&3)*1024)); vhi[i]=vtr(vp_+(((i)>>2)*4096+((i)&3)*1024+512)); }while(0)
  #define KRD(G,j) do{ if(G){ kload2(kf,kp0+sl_next,j); SBAR(); } }while(0)
  #define STEP(C0,C1,P0,P1,t,GK,GV,GL) do{ SBAR(); \
    const lds_cptr vp_=vp0+sl_prev; \
    VRD(0); SBAR(); float sacc=(P0[0]+P0[1]); \
    GAPA(C0=__builtin_amdgcn_mfma_f32_32x32x16_bf16(kf[0],qr[0],negm,0,0,0), P0[2],P0[3],P0[4],P0[5],     pw0[0]=PKW(P0,0), pw0[1]=PKW(P0,2), pw0); \
    VRD(4); SBAR(); GAPA(C1=__builtin_amdgcn_mfma_f32_32x32x16_bf16(kf[1],qr[0],negm,0,0,0), P0[6],P0[7],P0[8],P0[9],     pw0[2]=PKW(P0,4), pw0[3]=PKW(P0,6), pw0); \
    VRD(1); SBAR(); GAPA(C0=__builtin_amdgcn_mfma_f32_32x32x16_bf16(kf[2],qr[1],C0,0,0,0),   P0[10],P0[11],P0[12],P0[13], pw1[0]=PKW(P0,8), pw1[1]=PKW(P0,10), pw1); \
    VRD(5); SBAR(); GAPA(C1=__builtin_amdgcn_mfma_f32_32x32x16_bf16(kf[3],qr[1],C1,0,0,0),   P0[14],P0[15],P1[0],P1[1],   pw1[2]=PKW(P0,12),pw1[3]=PKW(P0,14), pw1); \
    VRD(2); SBAR(); GAPA(C0=__builtin_amdgcn_mfma_f32_32x32x16_bf16(kf[4],qr[2],C0,0,0,0),   P1[2],P1[3],P1[4],P1[5],     pw2[0]=PKW(P1,0), pw2[1]=PKW(P1,2), pw2); \
    VRD(6); SBAR(); GAPA(C1=__builtin_amdgcn_mfma_f32_32x32x16_bf16(kf[5],qr[2],C1,0,0,0),   P1[6],P1[7],P1[8],P1[9],     pw2[2]=PKW(P1,4), pw2[3]=PKW(P1,6), pw2); \
    VRD(3); SBAR(); GAPA(C0=__builtin_amdgcn_mfma_f32_32x32x16_bf16(kf[6],qr[3],C0,0,0,0),   P1[10],P1[11],P1[12],P1[13], pw3[0]=PKW(P1,8), pw3[1]=PKW(P1,10), pw3); \
    VRD(7); SBAR(); GAPA(C1=__builtin_amdgcn_mfma_f32_32x32x16_bf16(kf[7],qr[3],C1,0,0,0),   P1[14],P1[15],0.f,0.f,       pw3[2]=PKW(P1,12),pw3[3]=PKW(P1,14), pw3); \
    l_reg+=sacc; \
    if(GK){DMA_K((t)+3,sl_cur);} if(GV){DMA_V((t)+1,sl_next);} \
    CMASK(C0,C1,t); \
    { float a=MX3(C0[0],C0[1],C1[0]),b=MX3(C0[2],C0[3],C1[1]); a=MX3(a,C1[2],C1[3]); \
      _Pragma("unroll") for(int r=4;r<16;r+=4){a=MX3(a,C0[r],C0[r+1]);b=MX3(b,C0[r+2],C0[r+3]);a=MX3(a,C1[r],C1[r+1]);b=MX3(b,C1[r+2],C1[r+3]);} \
      float rm=__builtin_fmaxf(a,b); { auto rr=__builtin_amdgcn_permlane32_swap(__float_as_uint(rm),__float_as_uint(rm),false,false); rm=__builtin_fmaxf(__uint_as_float(rr[0]),__uint_as_float(rr[1])); } \
      resc=false; \
      if(__builtin_expect(__any(rm>(float)THRL),0)){ const float dl=__builtin_fmaxf(rm,0.f); mhat+=dl; \
        _Pragma("unroll") for(int r=0;r<16;++r){C0[r]-=dl;C1[r]-=dl;} \
        _Pragma("unroll") for(int r=0;r<16;++r)negm[r]=-mhat; asm volatile("":"+v"(negm)); \
        const float f=__builtin_amdgcn_exp2f(-dl); l_reg*=f; if(hi==0)wsf[r32]=f; resc=true; } } \
    SBAR(); \
    GAPB(o[0]=__builtin_amdgcn_mfma_f32_32x32x16_bf16(PAF(0),VFR(0),o[0],0,0,0), C0,0); \
    GAPB(o[1]=__builtin_amdgcn_mfma_f32_32x32x16_bf16(PAF(0),VFR(4),o[1],0,0,0), C0,4); \
    KRD(GL,0); GAPB(o[0]=__builtin_amdgcn_mfma_f32_32x32x16_bf16(PAF(1),VFR(1),o[0],0,0,0), C0,8); \
    KRD(GL,1); GAPB(o[1]=__builtin_amdgcn_mfma_f32_32x32x16_bf16(PAF(1),VFR(5),o[1],0,0,0), C0,12); \
    KRD(GL,2); GAPB(o[0]=__builtin_amdgcn_mfma_f32_32x32x16_bf16(PAF(2),VFR(2),o[0],0,0,0), C1,0); \
    KRD(GL,3); GAPB(o[1]=__builtin_amdgcn_mfma_f32_32x32x16_bf16(PAF(2),VFR(6),o[1],0,0,0), C1,4); \
    GAPB(o[0]=__builtin_amdgcn_mfma_f32_32x32x16_bf16(PAF(3),VFR(3),o[0],0,0,0), C1,8); \
    GAPB(o[1]=__builtin_amdgcn_mfma_f32_32x32x16_bf16(PAF(3),VFR(7),o[1],0,0,0), C1,12); \
    }while(0)
  int t=1;
  for(;t+5<NT;t+=2){
    STEP(pB0,pB1,pA0,pA1,t,true,true,true);     WAIT_BAR(2); RESC(); ROT();
    STEP(pA0,pA1,pB0,pB1,t+1,true,true,true);   WAIT_BAR(2); RESC(); ROT();
  }
  #define ENDW(tt) do{ if((tt)+3<NT){WAIT_BAR(2);} else if((tt)+2<NT){WAIT_BAR(1);} else {WAIT_BAR(0);} }while(0)
  for(;t+1<NT;t+=2){
    STEP(pB0,pB1,pA0,pA1,t,(t+3<NT),(t+1<NT),(t+1<NT));       ENDW(t);   RESC(); ROT();
    STEP(pA0,pA1,pB0,pB1,t+1,(t+4<NT),(t+2<NT),(t+2<NT));     ENDW(t+1); RESC(); ROT();
  }
  STEP(pB0,pB1,pA0,pA1,NT-1,false,false,false); RESC();
  { float sacc=pB0[0]+pB0[1]; _Pragma("unroll") for(int r=2;r<16;++r)sacc+=pB0[r]; _Pragma("unroll") for(int r=0;r<16;++r)sacc+=pB1[r]; l_reg+=sacc;
    pw0=(u32x4){PKW(pB0,0),PKW(pB0,2),PKW(pB0,4),PKW(pB0,6)};pw1=(u32x4){PKW(pB0,8),PKW(pB0,10),PKW(pB0,12),PKW(pB0,14)};pw2=(u32x4){PKW(pB1,0),PKW(pB1,2),PKW(pB1,4),PKW(pB1,6)};pw3=(u32x4){PKW(pB1,8),PKW(pB1,10),PKW(pB1,12),PKW(pB1,14)};
    SBAR(); pv(o,vb0+sl_cur,PAF(0),PAF(1),PAF(2),PAF(3)); }
  #undef PKW
  #undef PAF
  #undef VFR
  #undef PIN
  #undef MX3
  #undef GAPA
  #undef GAPB
  #undef EX
  #undef VRD
  #undef KRD
  #undef STEP
  #undef ENDW
  {auto rr=__builtin_amdgcn_permlane32_swap(__float_as_uint(l_reg),__float_as_uint(l_reg),false,false);l_reg=__uint_as_float(rr[0])+__uint_as_float(rr[1]);}
  if(hi==0)wsf[32+r32]=l_reg;asm volatile("s_waitcnt lgkmcnt(0)":::"memory");
  float rli[16];
  #pragma unroll
  for(int r=0;r<16;++r)rli[r]=__builtin_amdgcn_rcpf(wsf[32+crow(r,hi)]);
  bf16*Ow=Oh+(rowbase+q0+wid*QBLK)*PO;
  { bf16*stg=(bf16*)(shm+LDS_OST)+wid*2048;
    #pragma unroll
    for(int r=0;r<16;++r){const int orow=crow(r,hi);
      #pragma unroll
      for(int d0=0;d0<2;++d0)stg[orow*64+d0*32+r32]=__float2bfloat16(o[d0][r]*rli[r]);}
    asm volatile("s_waitcnt lgkmcnt(0)":::"memory");
    #pragma unroll
    for(int i=0;i<4;++i){const int row=i*8+(lane>>3),ch=lane&7; const u32x4 v=*(const u32x4*)(stg+row*64+ch*8); ATTN_STORE16(Ow+(long)row*PO+ch*8,v);} }
  asm volatile("s_waitcnt lgkmcnt(0)\n\ts_barrier":::"memory");
  #undef DMA_K
  #undef DMA_V
  #undef CMASK
  #undef START
  #undef RESC
  #undef ROT
}
constexpr int ATTN_LDS_BYTES=LDS_BYTES;
#undef SBAR
#undef WAIT_BAR
}
namespace mk {
typedef unsigned short bf16_t;
typedef unsigned u32x4 __attribute__((ext_vector_type(4)));
typedef float f32x4 __attribute__((ext_vector_type(4)));
typedef float f2v __attribute__((ext_vector_type(2)));
#define LAS __attribute__((address_space(3)))
constexpr int DM = 1024, MTOK = 65536, MHALF = 32768, INW = 2304, DFF = 2816, UPW = 5632, NLAYER = 4;
constexpr float ALPHA = 1.6817928305074290f, LN_EPS = 1e-6f;
constexpr size_t MiB = 1u << 20;
constexpr size_t WS_ROPE = 1 * MiB, WS_W = 4 * MiB, W_LAYER = 23 * MiB, W_IN = 0, W_O = 4608 * 1024, W_UP = 6656 * 1024, W_DOWN = 17920 * 1024;
constexpr size_t WS_XBF = 96 * MiB, WS_Z = 224 * MiB, WS_MIX = 512 * MiB, WS_H = 224 * MiB  , WS_EDGE = 640 * MiB, WS_SPA = 664 * MiB, WS_SPB = 672 * MiB  ,
                 WS_CDIN = 680 * MiB  , WS_CDUP = 681 * MiB  , WS_PIN = 682 * MiB  , WS_PUP = 684 * MiB  , WS_ONES = 688 * MiB, WS_EDGE2 = 689 * MiB  , WS_BAR = 0  , WS_END = 692 * MiB;
constexpr int BARST_OFF = 131072;
constexpr int ST_OFF = 131072 + 1024 + 8192;
constexpr int HALO_OFF = 131072 + 1024;
constexpr int LDS_BYTES = 147456;

__device__ __forceinline__ float bf2f(unsigned b) { return __uint_as_float(b << 16); }
__device__ __forceinline__ unsigned pk(float lo, float hi) { return pg8::cvt_pk_bf16(lo, hi); }
__device__ __forceinline__ void unpack8(u32x4 w, float* f) { f[0] = bf2f(w.x & 0xffffu); f[1] = bf2f(w.x >> 16); f[2] = bf2f(w.y & 0xffffu); f[3] = bf2f(w.y >> 16);
    f[4] = bf2f(w.z & 0xffffu); f[5] = bf2f(w.z >> 16); f[6] = bf2f(w.w & 0xffffu); f[7] = bf2f(w.w >> 16); }
template <int O> __device__ __forceinline__ float swz_xor(float v) { return __int_as_float(__builtin_amdgcn_ds_swizzle(__float_as_int(v), (O << 10) | 0x1f)); }
__device__ __forceinline__ float half_sum(float v) { v += swz_xor<1>(v); v += swz_xor<2>(v); v += swz_xor<4>(v); v += swz_xor<8>(v); v += swz_xor<16>(v); return v; }
__device__ __forceinline__ float wave_sum(float v) { v = half_sum(v); auto rr = __builtin_amdgcn_permlane32_swap(__float_as_uint(v), __float_as_uint(v), false, false); return __uint_as_float(rr[0]) + __uint_as_float(rr[1]); }
__device__ __forceinline__ void transpose_item(const float* W, int K, int N, bf16_t* WT, int pbase, int phalf, const float* gvec, const float* bvec, float2* PART, LAS float* scr, int item, int lane) {
    const int nblk = N / 32, kb = item / nblk, nb = item % nblk, k0 = 64 * kb, n0 = 32 * nb;
    int d0 = n0;
    if (phalf && n0 >= pbase) { const int v = (n0 - pbase) >= phalf ? 1 : 0, nn = n0 - pbase - v * phalf; d0 = pbase + 256 * (nn / 128) + 128 * v + (nn % 128); }
#pragma unroll 8
    for (int i = 0; i < 32; ++i) { const int kk = 2 * i + (lane >> 5); scr[kk * 33 + (lane & 31)] = W[(size_t)(k0 + kk) * N + n0 + (lane & 31)]; }
    asm volatile("s_waitcnt lgkmcnt(0)" ::: "memory");
    const int c = lane & 7;
    float gk[8], bk[8];
#pragma unroll
    for (int q = 0; q < 8; ++q) { gk[q] = gvec ? gvec[k0 + 8 * c + q] : 1.f; bk[q] = gvec ? bvec[k0 + 8 * c + q] : 0.f; }
#pragma unroll
    for (int j = 0; j < 4; ++j) { const int n = (lane >> 3) + 8 * j; const LAS float* sp = scr + (8 * c) * 33 + n;
        float w[8]; float ds = 0.f;
#pragma unroll
        for (int q = 0; q < 8; ++q) { const float x = sp[q * 33]; ds += bk[q] * x; w[q] = gk[q] * x; }
        u32x4 o; o.x = pk(w[0], w[1]); o.y = pk(w[2], w[3]); o.z = pk(w[4], w[5]); o.w = pk(w[6], w[7]);
        *(u32x4*)(WT + (size_t)(d0 + n) * K + k0 + 8 * c) = o;
        if (PART) {
            float cs = ((bf2f(o.x & 0xffffu) + bf2f(o.x >> 16)) + (bf2f(o.y & 0xffffu) + bf2f(o.y >> 16))) + ((bf2f(o.z & 0xffffu) + bf2f(o.z >> 16)) + (bf2f(o.w & 0xffffu) + bf2f(o.w >> 16)));
            cs += swz_xor<1>(cs); cs += swz_xor<2>(cs); cs += swz_xor<4>(cs); ds += swz_xor<1>(ds); ds += swz_xor<2>(ds); ds += swz_xor<4>(ds);
            if (c == 0) PART[(size_t)kb * N + d0 + n] = make_float2(cs, ds);
        }
    }
    asm volatile("s_waitcnt lgkmcnt(0)" ::: "memory");
}
template <bool NORM, bool WF32 = true, bool WB16 = true> __device__ __forceinline__ void row_pass(const float* src, float* dstf, bf16_t* dstb, const float* g, const float* b, int lane) {
    const f32x4* xr = (const f32x4*)src + lane;
    f32x4 v[4]; float s = 0.f;
#pragma unroll
    for (int j = 0; j < 4; ++j) { v[j] = xr[64 * j]; s += (v[j].x + v[j].y) + (v[j].z + v[j].w); }
    if (NORM) {
        const float mean = wave_sum(s) * (1.f / DM); float s2 = 0.f;
#pragma unroll
        for (int j = 0; j < 4; ++j) { v[j] = v[j] - mean; s2 += (v[j].x * v[j].x + v[j].y * v[j].y) + (v[j].z * v[j].z + v[j].w * v[j].w); }
        const float rstd = 1.f / sqrtf(wave_sum(s2) * (1.f / DM) + LN_EPS);
#pragma unroll
        for (int j = 0; j < 4; ++j) { const f32x4 gg = ((const f32x4*)g)[lane + 64 * j], bb = ((const f32x4*)b)[lane + 64 * j]; v[j] = v[j] * rstd * gg + bb; }
    }
    f32x4* of = (f32x4*)dstf + lane; unsigned long long* ob = (unsigned long long*)dstb + lane;
#pragma unroll
    for (int j = 0; j < 4; ++j) { if (WF32) of[64 * j] = v[j]; if (WB16) ob[64 * j] = (unsigned long long)pk(v[j].x, v[j].y) | ((unsigned long long)pk(v[j].z, v[j].w) << 32); }
}
__device__ __forceinline__ void tokpos(int m, int& t, int& S) { if (m < MHALF) { S = 4096; t = m & 4095; } else { S = 8192; t = (m - MHALF) & 8191; } }
__device__ __forceinline__ void prep_row(bf16_t* z, bf16_t* mix, int m, int lane, const float2* rope, const float* qn, const float* kn, const float* cw, const float* cb) {
    int t, S; tokpos(m, t, S);
    bf16_t* zr = z + (size_t)m * INW;
    const int p = lane & 31, hh = lane >> 5;
    const float2 cs = rope[t * 32 + p];
    const float gq0 = qn[2 * p], gq1 = qn[2 * p + 1], gk0 = kn[2 * p], gk1 = kn[2 * p + 1];
    {
        const int head = 8 + hh; unsigned* wp = (unsigned*)(zr + head * 64 + 2 * p); const unsigned w = *wp;
        const float x0 = bf2f(w & 0xffffu), x1 = bf2f(w >> 16);
        float ss = x0 * x0 + x1 * x1;
        ss = half_sum(ss);
        const float r = 1.f / sqrtf(ss * (1.f / 64.f) + LN_EPS);
        const bool isq = head < 8;
        const float y0 = x0 * r * (isq ? gq0 : gk0), y1 = x1 * r * (isq ? gq1 : gk1);
        float o0 = y0 * cs.x - y1 * cs.y, o1 = y0 * cs.y + y1 * cs.x;
        if (isq) { o0 *= attn_body::C2; o1 *= attn_body::C2; }
        *wp = pk(o0, o1);
    }
}
__device__ __forceinline__ void conv_mix_unit(const bf16_t* Z, bf16_t* mix, const float* E2, const float* cw, const float* cbias, long row0, int h, int t0, int S, int tid) {
    const int pm = (int)(row0 >> 8);
#pragma unroll
    for (int it = 0; it < 4; ++it) {
        const int idx = tid + 512 * it, r = idx >> 3, ch = h * 64 + (idx & 7) * 8; const size_t row = (size_t)row0 + r;
        float fb[8], cp[8];
        unpack8(*(const u32x4*)(Z + row * INW + 768 + ch), fb);
        if (r == 0 || r == 255) {
            const float* Ep = E2 + (size_t)pm * 4 * 512 + ch; const bool last = r == 255;
            const float* r0 = last ? Ep + 2 * 512 : Ep - 512; const float* r1 = last ? Ep + 3 * 512 : Ep; const float* r2 = last ? Ep + 4 * 512 : Ep + 512;
            const bool hasp = t0 + r > 0, hasn = t0 + r < S - 1;
#pragma unroll
            for (int i = 0; i < 8; ++i) cp[i] = cw[ch + i] * (hasp ? r0[i] : 0.f) + cw[512 + ch + i] * r1[i] + cw[1024 + ch + i] * (hasn ? r2[i] : 0.f) + cbias[ch + i];
        } else unpack8(*(const u32x4*)(Z + row * INW + 1280 + ch), cp);
        u32x4 w; w.x = pk(fb[0] * cp[0], fb[1] * cp[1]); w.y = pk(fb[2] * cp[2], fb[3] * cp[3]); w.z = pk(fb[4] * cp[4], fb[5] * cp[5]); w.w = pk(fb[6] * cp[6], fb[7] * cp[7]);
        *(u32x4*)(mix + row * DM + 512 + ch) = w;
    }
}
__device__ __forceinline__ void row_stats_to_lds(const float* SP, int pm, LAS f2v* T, int tid) {
    if (tid < 256) { const f32x4* p = (const f32x4*)(SP + (size_t)(pm * 256 + tid) * 32); float s1 = 0.f, s2 = 0.f;
#pragma unroll
        for (int k = 0; k < 8; ++k) { const f32x4 v = p[k]; s1 += v.x + v.z; s2 += v.y + v.w; }
        const float mu = s1 * (1.f / DM), var = s2 * (1.f / DM) - mu * mu;
        T[tid] = (f2v){mu, 1.f / sqrtf(var + LN_EPS)}; }
    asm volatile("s_waitcnt lgkmcnt(0)" ::: "memory"); __builtin_amdgcn_s_barrier(); asm volatile("" ::: "memory");
}
#define DPPF(old, src, ctrl) __int_as_float(__builtin_amdgcn_update_dpp(__float_as_int(old), __float_as_int(src), (ctrl), 0xf, 0xf, false))
#define DPPZ(src, ctrl) __int_as_float(__builtin_amdgcn_update_dpp(0, __float_as_int(src), (ctrl), 0xf, 0xf, true))
__device__ __forceinline__ float silu_mul(float G, float V) { return G * __builtin_amdgcn_rcpf(1.f + __builtin_amdgcn_exp2f(-1.4426950408889634f * G)) * V; }
struct EpiFfn {
    static constexpr bool PERM = true, AFTER_DRAIN = false;
    bf16_t* H; float* E; const float* fw; const float* fb; LAS float* R; const float* SP; const float* cvec; const float* dvec; LAS f2v* T; mutable int last_pm;
    __device__ __forceinline__ void operator()(pg8::f32x4 (&acc)[2][2][4][2], const pg8::Unit& u, int wr, int wc, int fr, int fq) const {
        typedef pg8::f32x4 f4;
        const int cidx = (wc * 4 + fq) * 16, cl = 32 * wc + 8 * fq;
        if (u.pm != last_pm) { row_stats_to_lds(SP, u.pm, T, (wr * 4 + wc) * 64 + fq * 16 + fr); last_pm = u.pm; }
#pragma unroll
        for (int bj = 0; bj < 2; ++bj)
#pragma unroll
            for (int n = 0; n < 2; ++n) { const f4 cv = *(const f4*)(cvec + u.pn * 256 + 128 * bj + cl + 4 * n), dv = *(const f4*)(dvec + u.pn * 256 + 128 * bj + cl + 4 * n);
#pragma unroll
                for (int ai = 0; ai < 2; ++ai)
#pragma unroll
                    for (int m = 0; m < 4; ++m) { const f2v st = T[ai * 128 + wr * 64 + m * 16 + fr]; acc[ai][bj][m][n] = acc[ai][bj][m][n] * st.y + (cv * (-st.x * st.y) + dv); } }
#pragma unroll
        for (int ai = 0; ai < 2; ++ai) { const int s = 2 * ai + wr;
            if (fr == 0) {
#pragma unroll
                for (int bj = 0; bj < 2; ++bj)
#pragma unroll
                    for (int n = 0; n < 2; ++n) *(LAS f4*)(R + (2 * s) * 256 + cidx + (bj * 2 + n) * 4) = acc[ai][bj][0][n]; }
            if (fr == 15) {
#pragma unroll
                for (int bj = 0; bj < 2; ++bj)
#pragma unroll
                    for (int n = 0; n < 2; ++n) *(LAS f4*)(R + (2 * s + 1) * 256 + cidx + (bj * 2 + n) * 4) = acc[ai][bj][3][n]; } }
        { float* Eb = E + (size_t)u.pm * 4 * UPW + u.pn * 256 + cl;
            if (wr == 0 && fr < 2) {
#pragma unroll
                for (int bj = 0; bj < 2; ++bj)
#pragma unroll
                    for (int n = 0; n < 2; ++n) *(f4*)(Eb + fr * UPW + 128 * bj + 4 * n) = acc[0][bj][0][n]; }
            if (wr == 1 && fr >= 14) {
#pragma unroll
                for (int bj = 0; bj < 2; ++bj)
#pragma unroll
                    for (int n = 0; n < 2; ++n) *(f4*)(Eb + (fr - 12) * UPW + 128 * bj + 4 * n) = acc[1][bj][3][n]; } }
        asm volatile("s_waitcnt lgkmcnt(0)" ::: "memory"); __builtin_amdgcn_s_barrier(); asm volatile("" ::: "memory");
#pragma unroll
        for (int n = 0; n < 2; ++n) {
            const int chg = 128 * u.pn + cl + 4 * n;
            const f4 w0g = *(const f4*)(fw + chg), w1g = *(const f4*)(fw + UPW + chg), w2g = *(const f4*)(fw + 2 * UPW + chg), bg = *(const f4*)(fb + chg);
            const f4 w0v = *(const f4*)(fw + DFF + chg), w1v = *(const f4*)(fw + UPW + DFF + chg), w2v = *(const f4*)(fw + 2 * UPW + DFF + chg), bv = *(const f4*)(fb + DFF + chg);
#pragma unroll
            for (int ai = 0; ai < 2; ++ai) { const int s = 2 * ai + wr;
                const int ra = (s > 0 ? 2 * s - 1 : 0) * 256 + cidx + n * 4, rb = (s < 3 ? 2 * s + 2 : 7) * 256 + cidx + n * 4;
                const f4 abg = *(const LAS f4*)(R + ra), abv = *(const LAS f4*)(R + ra + 8), beg = *(const LAS f4*)(R + rb), bev = *(const LAS f4*)(R + rb + 8);
#pragma unroll
                for (int e = 0; e < 4; ++e) {
                    float opg = 0.f, opv = 0.f;
#pragma unroll
                    for (int m = 0; m < 4; ++m) {
                        const float cg_ = acc[ai][0][m][n][e], cv_ = acc[ai][1][m][n][e];
                        float tg, tv, ng, nv;
                        if (m == 0) { tg = abg[e]; tv = abv[e]; } else { tg = DPPZ(opg, 0x10F); tv = DPPZ(opv, 0x10F); }
                        if (m == 3) { ng = beg[e]; nv = bev[e]; } else { ng = DPPZ(acc[ai][0][m + 1][n][e], 0x11F); nv = DPPZ(acc[ai][1][m + 1][n][e], 0x11F); }
                        const float pg_ = DPPF(tg, cg_, 0x111), pv_ = DPPF(tv, cv_, 0x111);
                        const float xg_ = DPPF(ng, cg_, 0x101), xv_ = DPPF(nv, cv_, 0x101);
                        const float Gv = w0g[e] * pg_ + w1g[e] * cg_ + w2g[e] * xg_ + bg[e];
                        const float Vv = w0v[e] * pv_ + w1v[e] * cv_ + w2v[e] * xv_ + bv[e];
                        opg = cg_; opv = cv_;
                        acc[ai][0][m][n][e] = silu_mul(Gv, Vv);
                    }
                    __builtin_amdgcn_sched_barrier(0);
                }
            }
        }
#pragma unroll
        for (int ai = 0; ai < 2; ++ai)
#pragma unroll
            for (int m = 0; m < 4; ++m) { bf16_t* p = H + (size_t)(u.pm * pg8::BM + ai * pg8::HALF + wr * 64 + m * 16 + fr) * DFF + 128 * u.pn + cl;
                const f4 v0 = acc[ai][0][m][0], v1 = acc[ai][0][m][1];
                u32x4 w; w.x = pk(v0[0], v0[1]); w.y = pk(v0[2], v0[3]); w.z = pk(v1[0], v1[1]); w.w = pk(v1[2], v1[3]);
                *(u32x4*)p = w; }
    }
};
__device__ __forceinline__ void ffn_fix_item(const float* E, bf16_t* H, int pm, int which, int ch, const float* fw, const float* fb) {
    const int m = pm * 256 + (which ? 255 : 0); int t, S; tokpos(m, t, S);
    const int j = ch >> 4, i8 = (ch & 15) * 8, ucg = 256 * j + i8, cg_ = 128 * j + i8, cv_ = DFF + cg_;
    const float* Ep = E + (size_t)pm * 4 * UPW + ucg;
    const float* r0 = which ? Ep + 2 * UPW : Ep - UPW;
    const float* r1 = which ? Ep + 3 * UPW : Ep;
    const float* r2 = which ? Ep + 4 * UPW : Ep + UPW;
    const bool hasp = t > 0, hasn = t < S - 1;
    float o[8];
#pragma unroll
    for (int i = 0; i < 8; ++i) {
        const float gm = hasp ? r0[i] : 0.f, vm = hasp ? r0[128 + i] : 0.f, gp = hasn ? r2[i] : 0.f, vp = hasn ? r2[128 + i] : 0.f;
        const float G = fw[cg_ + i] * gm + fw[UPW + cg_ + i] * r1[i] + fw[2 * UPW + cg_ + i] * gp + fb[cg_ + i];
        const float V = fw[cv_ + i] * vm + fw[UPW + cv_ + i] * r1[128 + i] + fw[2 * UPW + cv_ + i] * vp + fb[cv_ + i];
        o[i] = silu_mul(G, V);
    }
    u32x4 w; w.x = pk(o[0], o[1]); w.y = pk(o[2], o[3]); w.z = pk(o[4], o[5]); w.w = pk(o[6], o[7]);
    *(u32x4*)(H + (size_t)m * DFF + cg_) = w;
}
struct EpiZ {
    static constexpr bool PERM = true, AFTER_DRAIN = false;
    bf16_t* O; const float* SP; const float* cvec; const float* dvec; LAS f2v* T; float* E2; const float* cw; const float* cbias; LAS float* R; const float* rope; const float* kn; mutable int last_pm;
    __device__ __forceinline__ void store_tile(const pg8::f32x4 (&acc)[2][2][4][2], const pg8::Unit& u, int wr, int wc, int fr, int fq) const {
        typedef pg8::f32x4 f4;
        asm volatile("" : "+v"(fr));
        const int cbs = u.pn * 256 + wc * 32 + 8 * fq;
#pragma unroll
        for (int ai = 0; ai < 2; ++ai)
#pragma unroll
            for (int m = 0; m < 4; ++m) { bf16_t* rowp = O + (size_t)(u.pm * 256 + ai * 128 + wr * 64 + m * 16 + fr) * INW + cbs;
#pragma unroll
                for (int bj = 0; bj < 2; ++bj) { const f4 v0 = acc[ai][bj][m][0], v1 = acc[ai][bj][m][1];
                    u32x4 w; w.x = pk(v0[0], v0[1]); w.y = pk(v0[2], v0[3]); w.z = pk(v1[0], v1[1]); w.w = pk(v1[2], v1[3]);
                    *(u32x4*)(rowp + bj * 128) = w; } }
    }
    __device__ __forceinline__ void conv_tile(pg8::f32x4 (&acc)[2][2][4][2], const pg8::Unit& u, int wr, int wc, int fr, int fq) const {
        typedef pg8::f32x4 f4;
        const int cidx = (wc * 4 + fq) * 8, cl = 32 * wc + 8 * fq, jt = u.pn - 5;
#pragma unroll
        for (int ai = 0; ai < 2; ++ai)
#pragma unroll
            for (int m = 0; m < 4; ++m)
#pragma unroll
                for (int n = 0; n < 2; ++n) acc[ai][0][m][n] = acc[ai][0][m][n] * acc[ai][1][m][n];
#pragma unroll
        for (int ai = 0; ai < 2; ++ai) { const int s = 2 * ai + wr;
            if (fr == 0) {
#pragma unroll
                for (int n = 0; n < 2; ++n) *(LAS f4*)(R + (2 * s) * 128 + cidx + n * 4) = acc[ai][0][0][n]; }
            if (fr == 15) {
#pragma unroll
                for (int n = 0; n < 2; ++n) *(LAS f4*)(R + (2 * s + 1) * 128 + cidx + n * 4) = acc[ai][0][3][n]; } }
        { float* Eb = E2 + (size_t)u.pm * 4 * 512 + jt * 128 + cl;
            if (wr == 0 && fr < 2) {
#pragma unroll
                for (int n = 0; n < 2; ++n) *(f4*)(Eb + fr * 512 + 4 * n) = acc[0][0][0][n]; }
            if (wr == 1 && fr >= 14) {
#pragma unroll
                for (int n = 0; n < 2; ++n) *(f4*)(Eb + (fr - 12) * 512 + 4 * n) = acc[1][0][3][n]; } }
        asm volatile("s_waitcnt lgkmcnt(0)" ::: "memory"); __builtin_amdgcn_s_barrier(); asm volatile("" ::: "memory");
#pragma unroll
        for (int n = 0; n < 2; ++n) {
            const int ch = 128 * jt + cl + 4 * n;
            const f4 w0 = *(const f4*)(cw + ch), w1 = *(const f4*)(cw + 512 + ch), w2 = *(const f4*)(cw + 1024 + ch), bb = *(const f4*)(cbias + ch);
#pragma unroll
            for (int ai = 0; ai < 2; ++ai) { const int s = 2 * ai + wr;
                const int ra = (s > 0 ? 2 * s - 1 : 0) * 128 + cidx + n * 4, rb = (s < 3 ? 2 * s + 2 : 7) * 128 + cidx + n * 4;
                const f4 ab = *(const LAS f4*)(R + ra), be = *(const LAS f4*)(R + rb);
#pragma unroll
                for (int e = 0; e < 4; ++e) {
#pragma unroll
                    for (int m = 0; m < 4; ++m) {
                        const float c_ = acc[ai][0][m][n][e];
                        const float tp = (m == 0) ? ab[e] : DPPZ(acc[ai][0][m - 1][n][e], 0x10F);
                        const float tn = (m == 3) ? be[e] : DPPZ(acc[ai][0][m + 1][n][e], 0x11F);
                        const float pv_ = DPPF(tp, c_, 0x111), nx_ = DPPF(tn, c_, 0x101);
                        acc[ai][1][m][n][e] = w0[e] * pv_ + w1[e] * c_ + w2[e] * nx_ + bb[e];
                    }
                    __builtin_amdgcn_sched_barrier(0);
                }
            }
        }
#pragma unroll
        for (int ai = 0; ai < 2; ++ai)
#pragma unroll
            for (int m = 0; m < 4; ++m) { bf16_t* p = O + (size_t)(u.pm * 256 + ai * 128 + wr * 64 + m * 16 + fr) * INW + 1280 + 128 * jt + cl;
                const f4 v0 = acc[ai][1][m][0], v1 = acc[ai][1][m][1];
                u32x4 w; w.x = pk(v0[0], v0[1]); w.y = pk(v0[2], v0[3]); w.z = pk(v1[0], v1[1]); w.w = pk(v1[2], v1[3]);
                *(u32x4*)p = w; }
    }
    __device__ __forceinline__ void operator()(pg8::f32x4 (&acc)[2][2][4][2], const pg8::Unit& u, int wr, int wc, int fr, int fq) const {
        typedef pg8::f32x4 f4;
        if (u.pm != last_pm) { row_stats_to_lds(SP, u.pm, T, (wr * 4 + wc) * 64 + fq * 16 + fr); last_pm = u.pm; }
        const int cb = u.pn * 256 + wc * 32 + 8 * fq;
        f4 cv[2][2], dv[2][2];
#pragma unroll
        for (int bj = 0; bj < 2; ++bj)
#pragma unroll
            for (int n = 0; n < 2; ++n) { cv[bj][n] = *(const f4*)(cvec + cb + 128 * bj + 4 * n); dv[bj][n] = *(const f4*)(dvec + cb + 128 * bj + 4 * n); }
#pragma unroll
        for (int ai = 0; ai < 2; ++ai)
#pragma unroll
            for (int m = 0; m < 4; ++m) { const int rl = ai * 128 + wr * 64 + m * 16 + fr; const f2v st = T[rl]; const float r = st.y, rm = -st.x * st.y;
#pragma unroll
                for (int bj = 0; bj < 2; ++bj) { acc[ai][bj][m][0] = acc[ai][bj][m][0] * r + (cv[bj][0] * rm + dv[bj][0]); acc[ai][bj][m][1] = acc[ai][bj][m][1] * r + (cv[bj][1] * rm + dv[bj][1]); } }
        if (u.pn >= 5) { conv_tile(acc, u, wr, wc, fr, fq); return; }
        if (u.pn == 2) {
            float part[2][4];
            asm volatile("" : "+v"(fr), "+v"(fq));
#pragma unroll
            for (int ai = 0; ai < 2; ++ai)
#pragma unroll
                for (int m = 0; m < 4; ++m) { const f4 a0 = acc[ai][0][m][0], a1 = acc[ai][0][m][1];
                    float ss = ((a0[0] * a0[0] + a0[1] * a0[1]) + (a0[2] * a0[2] + a0[3] * a0[3])) + ((a1[0] * a1[0] + a1[1] * a1[1]) + (a1[2] * a1[2] + a1[3] * a1[3]));
                    ss += swz_xor<16>(ss); { auto rr = __builtin_amdgcn_permlane32_swap(__float_as_uint(ss), __float_as_uint(ss), false, false); ss = __uint_as_float(rr[0]) + __uint_as_float(rr[1]); }
                    part[ai][m] = ss; if (fq == 0) R[(ai * 128 + wr * 64 + m * 16 + fr) * 4 + wc] = ss; }
            asm volatile("s_waitcnt lgkmcnt(0)" ::: "memory"); __builtin_amdgcn_s_barrier(); asm volatile("" ::: "memory");
            const int dim0 = (wc & 1) * 32 + 8 * fq;
            const f4 g0 = *(const f4*)(kn + dim0), g1 = *(const f4*)(kn + dim0 + 4);
#pragma unroll
            for (int ai = 0; ai < 2; ++ai)
#pragma unroll
                for (int m = 0; m < 4; ++m) { const int rl = ai * 128 + wr * 64 + m * 16 + fr;
                    const float tot = part[ai][m] + R[rl * 4 + (wc ^ 1)], rn = 1.f / sqrtf(tot * (1.f / 64.f) + LN_EPS);
                    int t, S; tokpos(u.pm * 256 + rl, t, S);
                    const float* rp = rope + ((size_t)t * 32 + (dim0 >> 1)) * 2;
                    const f4 c01 = *(const f4*)rp, c23 = *(const f4*)(rp + 4);
                    const f4 a0 = acc[ai][0][m][0] * rn * g0, a1 = acc[ai][0][m][1] * rn * g1;
                    acc[ai][0][m][0] = (f4){a0[0] * c01[0] - a0[1] * c01[1], a0[0] * c01[1] + a0[1] * c01[0], a0[2] * c01[2] - a0[3] * c01[3], a0[2] * c01[3] + a0[3] * c01[2]};
                    acc[ai][0][m][1] = (f4){a1[0] * c23[0] - a1[1] * c23[1], a1[0] * c23[1] + a1[1] * c23[0], a1[2] * c23[2] - a1[3] * c23[3], a1[2] * c23[3] + a1[3] * c23[2]};
                    asm volatile("" ::: "memory"); __builtin_amdgcn_sched_barrier(0); }
            store_tile(acc, u, wr, wc, fr, fq); return;
        }
        store_tile(acc, u, wr, wc, fr, fq);
    }
};
struct EpiResLn {
    static constexpr bool PERM = true, AFTER_DRAIN = false;
    float* X; bf16_t* XB; const float* SPin; float* SPout; const float* g; const float* b; LAS f2v* T; float alpha;
    __device__ __forceinline__ void operator()(pg8::f32x4 (&acc)[2][2][4][2], const pg8::Unit& u, int wr, int wc, int fr, int fq) const {
        typedef pg8::f32x4 f4;
        row_stats_to_lds(SPin, u.pm, T, (wr * 4 + wc) * 64 + fq * 16 + fr);
        const int cb = u.pn * 256 + wc * 32 + 8 * fq;
        f4 gv[2][2], bv[2][2];
#pragma unroll
        for (int bj = 0; bj < 2; ++bj)
#pragma unroll
            for (int n = 0; n < 2; ++n) { gv[bj][n] = *(const f4*)(g + cb + 128 * bj + 4 * n); bv[bj][n] = *(const f4*)(b + cb + 128 * bj + 4 * n); }
#pragma unroll
        for (int ai = 0; ai < 2; ++ai)
#pragma unroll
            for (int m = 0; m < 4; ++m) { const int rl = ai * 128 + wr * 64 + m * 16 + fr; const f2v st = T[rl]; const float r = st.y, rm = -st.x * st.y;
                const size_t off = (size_t)(u.pm * 256 + rl) * DM + cb; float s1 = 0.f, s2 = 0.f;
#pragma unroll
                for (int bj = 0; bj < 2; ++bj) { f4 pre[2]; float xin[8]; unpack8(*(const u32x4*)(XB + off + 128 * bj), xin);
#pragma unroll
                    for (int n = 0; n < 2; ++n) { const f4 v = {xin[4 * n], xin[4 * n + 1], xin[4 * n + 2], xin[4 * n + 3]}; const f4 xr = (v * r + rm) * gv[bj][n] + bv[bj][n];
                        pre[n] = xr * alpha + acc[ai][bj][m][n]; if (X) *(f4*)(X + off + 128 * bj + 4 * n) = pre[n];
                        s1 += (pre[n][0] + pre[n][1]) + (pre[n][2] + pre[n][3]); s2 += (pre[n][0] * pre[n][0] + pre[n][1] * pre[n][1]) + (pre[n][2] * pre[n][2] + pre[n][3] * pre[n][3]); }
                    u32x4 w; w.x = pk(pre[0][0], pre[0][1]); w.y = pk(pre[0][2], pre[0][3]); w.z = pk(pre[1][0], pre[1][1]); w.w = pk(pre[1][2], pre[1][3]);
                    if (!X) *(u32x4*)(XB + off + 128 * bj) = w; }
                s1 += swz_xor<16>(s1); s2 += swz_xor<16>(s2);
                { auto r1 = __builtin_amdgcn_permlane32_swap(__float_as_uint(s1), __float_as_uint(s1), false, false); s1 = __uint_as_float(r1[0]) + __uint_as_float(r1[1]);
                  auto r2 = __builtin_amdgcn_permlane32_swap(__float_as_uint(s2), __float_as_uint(s2), false, false); s2 = __uint_as_float(r2[0]) + __uint_as_float(r2[1]); }
                if (fq == 0) *(f2v*)(SPout + (size_t)(u.pm * 256 + rl) * 32 + (u.pn * 4 + wc) * 2) = (f2v){s1, s2};
            }
    }
};

#define XB_TMO      128
#define XB_XCNT(j)  (256  + 64 * (j))
#define XB_XSUB(j)  (1280 + 64 * (j))
#define XB_XGEN(j)  (2304 + 64 * (j))
#define XB_TOP      3328
#define XB_TOPGEN   3392
#define XCD_BAR_WORDS 3456
#define XB_SPIN_CAP (1u << 18)

__device__ __forceinline__ unsigned xb_ld(unsigned* p)              { return __hip_atomic_load(p, __ATOMIC_RELAXED, __HIP_MEMORY_SCOPE_AGENT); }
__device__ __forceinline__ unsigned xb_add(unsigned* p, unsigned v) { return __hip_atomic_fetch_add(p, v, __ATOMIC_RELAXED, __HIP_MEMORY_SCOPE_AGENT); }
__device__ __forceinline__ unsigned xb_xcc_id() { return (unsigned)__builtin_amdgcn_s_getreg((3 << 11) | 20) & 0xFu; }
#define XB_SPIN(cond, bar) do { unsigned _sp = 0; while (cond) { __builtin_amdgcn_s_sleep(1); \
    if ((++_sp & 255u) == 0u) { if (xb_ld(&(bar)[XB_TMO])) break; if (_sp > XB_SPIN_CAP) { atomicAdd(&(bar)[XB_TMO], 1u); break; } } } } while (0)

struct XcdBarrier {
    unsigned* bar; unsigned x;
    volatile LAS unsigned* st;
};

__device__ __forceinline__ XcdBarrier xcd_barrier_post(unsigned* bar, volatile LAS unsigned* st) {
    XcdBarrier b; b.bar = bar; b.x = xb_xcc_id(); b.st = st;
    if (threadIdx.x == 0) (void)xb_add(&bar[XB_XCNT(b.x)], 1u);
    return b;
}
__device__ __forceinline__ void xcd_barrier_complete(unsigned* bar, unsigned x, unsigned& nloc, unsigned& nx) {
    const unsigned G = gridDim.x * gridDim.y * gridDim.z;
    unsigned sum, cnt, mine, sp = 0u;
    for (;;) {
        sum = 0u; cnt = 0u; mine = 0u;
#pragma unroll
        for (unsigned j = 0; j < 16; ++j) { const unsigned c = xb_ld(&bar[XB_XCNT(j)]); sum += c; cnt += (c > 0u) ? 1u : 0u; mine = (j == x) ? c : mine; }
        if (sum == G) break;
        __builtin_amdgcn_s_sleep(1);
        if ((++sp & 255u) == 0u) { if (xb_ld(&bar[XB_TMO])) break; if (sp > XB_SPIN_CAP) { atomicAdd(&bar[XB_TMO], 1u); break; } }
    }
    nloc = mine > 0u ? mine : 1u; nx = cnt > 0u ? cnt : 1u;
}

__device__ __forceinline__ void xcd_barrier(const XcdBarrier& b) {
    asm volatile("s_waitcnt vmcnt(0)" ::: "memory");
    __syncthreads();
    if (threadIdx.x == 0) {
        unsigned* bar = b.bar;
        __builtin_amdgcn_s_waitcnt(0);
        unsigned nloc = b.st[0], nx = b.st[1];
        if (nloc == 0u) { xcd_barrier_complete(bar, b.x, nloc, nx); b.st[0] = nloc; b.st[1] = nx; }
        const unsigned old = xb_add(&bar[XB_XSUB(b.x)], 1u);
        const unsigned gen = old / nloc;
        if (old + 1u == (gen + 1u) * nloc) {
            __builtin_amdgcn_fence(__ATOMIC_RELEASE, "agent");
            asm volatile("s_waitcnt vmcnt(0)" ::: "memory");
            const unsigned og = xb_add(&bar[XB_TOP], 1u);
            const unsigned tg = og / nx;
            if (og + 1u == (tg + 1u) * nx) xb_add(&bar[XB_TOPGEN], 1u);
            else XB_SPIN(xb_ld(&bar[XB_TOPGEN]) == tg, bar);
            __builtin_amdgcn_fence(__ATOMIC_ACQUIRE, "agent");
            xb_add(&bar[XB_XGEN(b.x)], 1u);
            asm volatile("s_waitcnt vmcnt(0)" ::: "memory");
        } else {
            XB_SPIN(xb_ld(&bar[XB_XGEN(b.x)]) == gen, bar);
            __builtin_amdgcn_fence(__ATOMIC_ACQUIRE, "agent");
            asm volatile("s_waitcnt vmcnt(0)" ::: "memory");
        }
    }
    __syncthreads();
}

struct Args { const float* in[16]; float* out; unsigned char* ws; };

#define ENV() \
    const __attribute__((address_space(4))) Args* ap = kp; asm volatile("" : "+s"(ap)); \
    int tid = threadIdx.x; asm volatile("" : "+v"(tid)); \
    const int lane = tid & 63, wave = __builtin_amdgcn_readfirstlane(tid >> 6); \
    const int G = gridDim.x, bx = blockIdx.x; \
    const int vcu = (G % 8 == 0) ? (bx % 8) * (G / 8) + bx / 8 : bx; \
    const int gw = vcu * 8 + wave, NGW = G * 8; \
    const size_t gtid = (size_t)bx * 512 + tid, gsz = (size_t)G * 512; \
    unsigned char* ws = ap->ws; float* X = ap->out; \
    bf16_t* XBF = (bf16_t*)(ws + WS_XBF); bf16_t* Z = (bf16_t*)(ws + WS_Z); bf16_t* MIX = (bf16_t*)(ws + WS_MIX); \
    bf16_t* H = (bf16_t*)(ws + WS_H); float* EDGE = (float*)(ws + WS_EDGE); float2* ROPE = (float2*)(ws + WS_ROPE); \
    float* SPA = (float*)(ws + WS_SPA); float* SPB = (float*)(ws + WS_SPB); float* CDIN = (float*)(ws + WS_CDIN); float* CDUP = (float*)(ws + WS_CDUP); \
    float2* PIN = (float2*)(ws + WS_PIN); float2* PUP = (float2*)(ws + WS_PUP); float* ONES = (float*)(ws + WS_ONES); float* EDGE2 = (float*)(ws + WS_EDGE2); (void)EDGE2; LAS f2v* TST = (LAS f2v*)((LAS unsigned char*)lds + ST_OFF); \
    (void)SPA; (void)SPB; (void)CDIN; (void)CDUP; (void)PIN; (void)PUP; (void)ONES; (void)TST; \
    (void)lane; (void)wave; (void)gw; (void)NGW; (void)gtid; (void)gsz; (void)X; (void)XBF; (void)Z; (void)MIX; (void)EDGE; (void)H; (void)ROPE;

__global__ void __launch_bounds__(512, 2) mega_fwd(Args a_unused) {
    extern __shared__ __attribute__((aligned(16))) unsigned char lds[];
    cg::grid_group grid = cg::this_grid();
    const __attribute__((address_space(4))) Args* kp = (const __attribute__((address_space(4))) Args*)__builtin_amdgcn_kernarg_segment_ptr();

    if (threadIdx.x < 2) ((volatile LAS unsigned*)((LAS unsigned char*)lds + BARST_OFF))[threadIdx.x] = 0u;
    __syncthreads();
    {
        ENV();
        if (bx == 0) for (int i = tid; i < XCD_BAR_WORDS; i += 512) ((unsigned*)(ws + WS_BAR))[i] = 0u;
        LAS float* scr = (LAS float*)((LAS unsigned char*)lds + wave * 16384);
        constexpr int I_IN = 16 * 72, I_O = 16 * 32, I_UP = 16 * 176, I_DN = 44 * 32, I_L = I_IN + I_O + I_UP + I_DN;
        for (int it = gw; it < NLAYER * I_L; it += NGW) {
            const int l = it / I_L; int r = it % I_L; unsigned char* wl = ws + WS_W + (size_t)l * W_LAYER;
            if (r < I_IN) { const bool f = l > 0;
                transpose_item(ap->in[2] + (size_t)l * DM * INW, DM, INW, (bf16_t*)(wl + W_IN), 1280, 512, f ? ap->in[14] + (l - 1) * DM : nullptr, f ? ap->in[15] + (l - 1) * DM : nullptr,
                               f ? PIN + (size_t)l * 16 * INW : nullptr, scr, r, lane); continue; } r -= I_IN;
            if (r < I_O) { transpose_item(ap->in[7] + (size_t)l * DM * DM, DM, DM, (bf16_t*)(wl + W_O), 0, 0, nullptr, nullptr, nullptr, scr, r, lane); continue; } r -= I_O;
            if (r < I_UP) { transpose_item(ap->in[10] + (size_t)l * DM * UPW, DM, UPW, (bf16_t*)(wl + W_UP), 0, DFF, ap->in[8] + l * DM, ap->in[9] + l * DM, PUP + (size_t)l * 16 * UPW, scr, r, lane); continue; } r -= I_UP;
            transpose_item(ap->in[13] + (size_t)l * DFF * DM, DFF, DM, (bf16_t*)(wl + W_DOWN), 0, 0, nullptr, nullptr, nullptr, scr, r, lane);
        }
        for (size_t i = gtid; i < (size_t)MTOK * 8; i += gsz) ((f32x4*)SPB)[i] = (i & 7) == 0 ? (f32x4){0.f, (float)DM * (1.f - LN_EPS), 0.f, 0.f} : (f32x4){0.f, 0.f, 0.f, 0.f};
        for (size_t i = gtid; i < 2048; i += gsz) ONES[i] = i < 1024 ? 1.f : 0.f;
        for (size_t i = gtid; i < 2 * INW; i += gsz) CDIN[i] = 0.f;
        for (size_t i = gtid; i < 8192 * 32; i += gsz) {
            const int t = (int)(i >> 5), p = (int)(i & 31); const int pos = p < 16 ? (t >> 6) : (t & 63);
            const float angf = (float)pos * __builtin_amdgcn_exp2f(-(float)(p & 15) * 0.83048202372184059f);
            double r = (double)angf; r -= 6.283185307179586476925 * __builtin_rint(r * 0.15915494309189533577);
            const double r2 = r * r; double sn, cs;
            sn = -1.0 / 51090942171709440000.0; cs = 1.0 / 2432902008176640000.0;
            sn = sn * r2 + 1.0 / 121645100408832000.0; cs = cs * r2 - 1.0 / 6402373705728000.0;
            sn = sn * r2 - 1.0 / 355687428096000.0;    cs = cs * r2 + 1.0 / 20922789888000.0;
            sn = sn * r2 + 1.0 / 1307674368000.0;      cs = cs * r2 - 1.0 / 87178291200.0;
            sn = sn * r2 - 1.0 / 6227020800.0;         cs = cs * r2 + 1.0 / 479001600.0;
            sn = sn * r2 + 1.0 / 39916800.0;           cs = cs * r2 - 1.0 / 3628800.0;
            sn = sn * r2 - 1.0 / 362880.0;             cs = cs * r2 + 1.0 / 40320.0;
            sn = sn * r2 + 1.0 / 5040.0;               cs = cs * r2 - 1.0 / 720.0;
            sn = sn * r2 - 1.0 / 120.0;                cs = cs * r2 + 1.0 / 24.0;
            sn = sn * r2 + 1.0 / 6.0;                  cs = cs * r2 - 1.0 / 2.0;
            sn = sn * r2 - 1.0; sn = -sn * r;          cs = cs * r2 + 1.0;
            ROPE[i] = make_float2((float)cs, (float)sn);
        }
        for (int m = gw; m < MTOK; m += NGW) {
            const float* src = m < MHALF ? ap->in[0] + (size_t)m * DM : ap->in[1] + (size_t)(m - MHALF) * DM;
            row_pass<false, false>(src, nullptr, XBF + (size_t)m * DM, nullptr, nullptr, lane);
        }
    }
    grid.sync();
    const XcdBarrier xbar = xcd_barrier_post((unsigned*)(kp->ws + WS_BAR), (volatile LAS unsigned*)((LAS unsigned char*)lds + BARST_OFF));

#pragma nounroll
    for (int l = 0; l < NLAYER; ++l) {
        {
            ENV(); unsigned char* wl = ws + WS_W + (size_t)l * W_LAYER;
            pg8::Gemm g{XBF, (const bf16_t*)(wl + W_IN), MTOK, INW, DM}; pg8::StaticOrder S; S.init(MTOK, INW, G, bx);
            EpiZ E{Z, SPB, CDIN + (size_t)l * 2 * INW, CDIN + (size_t)l * 2 * INW + INW, TST, EDGE2, ap->in[5] + l * 3 * 512, ap->in[6] + l * 512, (LAS float*)((LAS unsigned char*)lds + HALO_OFF), (const float*)ROPE, ap->in[4] + l * 64, -1};
            pg8::gemm_phase<EpiZ, pg8::StaticOrder, true, true>((LAS unsigned char*)lds, g, S, E);
        }
        xcd_barrier(xbar);
        {
            ENV();
            if (l == 0) {
                for (size_t i = gtid; i < (size_t)3 * INW + 4 * UPW; i += gsz) {
                    const bool up = i >= (size_t)3 * INW; const int N = up ? UPW : INW; const int r = up ? (int)(i - 3 * INW) : (int)i + INW, ll = r / N, n = r % N;
                    const float2* P = (up ? PUP : PIN) + (size_t)ll * 16 * N + n; float cs = 0.f, ds = 0.f;
#pragma unroll
                    for (int kb = 0; kb < 16; ++kb) { const float2 v = P[(size_t)kb * N]; cs += v.x; ds += v.y; }
                    float* CD = (up ? CDUP : CDIN) + (size_t)ll * 2 * N; CD[n] = cs; CD[N + n] = ds;
                }
            }
            const int xcd = vcu >> 5, jc = vcu & 31;
#pragma nounroll
            for (int i = 0; i < 8; ++i) {
                long rowbase; int NT, qb, h, kvh;
                if (i < 4) { const int ui = jc * 4 + i; kvh = xcd & 1; h = kvh * 4 + (ui >> 5); qb = ui & 31; rowbase = MHALF + (long)(xcd >> 1) * 8192; NT = 128; }
                else { const int ui = jc * 4 + (i - 4), pair = 2 * xcd + (ui >> 6), r = ui & 63; kvh = pair & 1; h = kvh * 4 + (r >> 4); qb = r & 15; rowbase = (long)(pair >> 1) * 4096; NT = 64; }
                attn_body::attn_unit<8>(rowbase, NT, qb * 256, (const attn_body::bf16*)(Z + h * 64), (const attn_body::bf16*)(Z + 512 + kvh * 64), (const attn_body::bf16*)(Z + 640 + kvh * 64),
                                        (attn_body::bf16*)(MIX + h * 64), (char*)lds, (const float*)ROPE, ap->in[3] + l * 64);
                conv_mix_unit(Z, MIX, EDGE2, ap->in[5] + l * 3 * 512, ap->in[6] + l * 512, rowbase + qb * 256, h, qb * 256, NT * 64, tid);
            }
        }
        xcd_barrier(xbar);
        {
            ENV(); unsigned char* wl = ws + WS_W + (size_t)l * W_LAYER;
            pg8::Gemm g{MIX, (const bf16_t*)(wl + W_O), MTOK, DM, DM}; pg8::StaticOrder S; S.init(MTOK, DM, G, bx);
            EpiResLn E{nullptr, XBF, SPB, SPA, l > 0 ? ap->in[14] + (l - 1) * DM : ONES, l > 0 ? ap->in[15] + (l - 1) * DM : ONES + 1024, TST, ALPHA};
            pg8::gemm_phase<EpiResLn, pg8::StaticOrder, true, true>((LAS unsigned char*)lds, g, S, E);
        }
        xcd_barrier(xbar);
        {
            ENV(); unsigned char* wl = ws + WS_W + (size_t)l * W_LAYER;
            pg8::Gemm g{XBF, (const bf16_t*)(wl + W_UP), MTOK, UPW, DM}; pg8::StaticOrder S; S.init(MTOK, UPW, G, bx);
            EpiFfn E{H, EDGE, ap->in[11] + (size_t)l * 3 * UPW, ap->in[12] + (size_t)l * UPW, (LAS float*)((LAS unsigned char*)lds + HALO_OFF), SPA, CDUP + (size_t)l * 2 * UPW, CDUP + (size_t)l * 2 * UPW + UPW, TST, -1};
            pg8::gemm_phase<EpiFfn, pg8::StaticOrder, true, true>((LAS unsigned char*)lds, g, S, E);
        }
        xcd_barrier(xbar);
        {
            ENV();
            const float* fw = ap->in[11] + (size_t)l * 3 * UPW; const float* fb = ap->in[12] + (size_t)l * UPW;
            for (size_t it = gtid; it < (size_t)512 * 352; it += gsz) { const int rr = (int)(it / 352), ch = (int)(it % 352); ffn_fix_item(EDGE, H, rr >> 1, rr & 1, ch, fw, fb); }
        }
        xcd_barrier(xbar);
        {
            ENV(); unsigned char* wl = ws + WS_W + (size_t)l * W_LAYER;
            pg8::Gemm g{H, (const bf16_t*)(wl + W_DOWN), MTOK, DM, DFF}; pg8::StaticOrder S; S.init(MTOK, DM, G, bx);
            EpiResLn E{l == NLAYER - 1 ? X : nullptr, XBF, SPA, SPB, ap->in[8] + l * DM, ap->in[9] + l * DM, TST, ALPHA};
            pg8::gemm_phase<EpiResLn, pg8::StaticOrder, true, true>((LAS unsigned char*)lds, g, S, E);
        }
        xcd_barrier(xbar);
    }
    {
        ENV();
        for (int m = gw; m < MTOK; m += NGW) row_pass<true, true, false>(X + (size_t)m * DM, X + (size_t)m * DM, nullptr, ap->in[14] + (NLAYER - 1) * DM, ap->in[15] + (NLAYER - 1) * DM, lane);
    }
}
}

extern "C" void kernel_launch(void* const* d_in, const int* in_sizes, int n_in, void* d_out, int out_size, void* d_ws, size_t ws_size, hipStream_t stream) {
    static int grid = 0;
    if (grid == 0) {
        if (n_in != 16 || out_size != mk::MTOK * mk::DM || ws_size < mk::WS_END) { fprintf(stderr, "kernel_launch: unexpected shapes (n_in %d out %d ws %zu)\n", n_in, out_size, ws_size); grid = -1; return; }
        int dev = 0, cus = 0, per_cu = 0;
        (void)hipGetDevice(&dev);
        (void)hipDeviceGetAttribute(&cus, hipDeviceAttributeMultiprocessorCount, dev);
        (void)hipFuncSetAttribute((const void*)mk::mega_fwd, hipFuncAttributeMaxDynamicSharedMemorySize, mk::LDS_BYTES);
        (void)hipOccupancyMaxActiveBlocksPerMultiprocessor(&per_cu, (const void*)mk::mega_fwd, 512, mk::LDS_BYTES);
        (void)hipGetLastError();
        grid = cus;
        fprintf(stderr, "kernel_launch: cus %d per_cu %d grid %d\n", cus, per_cu, grid);
    }
    if (grid < 0) return;
    mk::Args a{};
    for (int i = 0; i < 16; ++i) a.in[i] = (const float*)d_in[i];
    a.out = (float*)d_out; a.ws = (unsigned char*)d_ws;
    void* args[] = {&a};
    hipError_t e = hipLaunchCooperativeKernel((const void*)mk::mega_fwd, dim3(grid), dim3(512), args, mk::LDS_BYTES, stream);
    if (e != hipSuccess) fprintf(stderr, "cooperative launch failed: %s (grid %d)\n", hipGetErrorString(e), grid);
}
```

```cpp
#include <hip/hip_runtime.h>
#include <hip/hip_cooperative_groups.h>
#include <cstdio>
#include <cstdint>
#include <cmath>
namespace cg = cooperative_groups;

namespace pg8 {

#define PG8_LAS __attribute__((address_space(3)))
typedef unsigned short bf16_t;
typedef short bf16x8 __attribute__((ext_vector_type(8)));
typedef float f32x4 __attribute__((ext_vector_type(4)));
typedef unsigned u32x4 __attribute__((ext_vector_type(4)));
constexpr int BM = 256, BK = 64, HALF = 128, HTB = HALF * BK * 2  , STAGE_BYTES = 8 * HTB, NXCD = 8, WGM = 8;

__host__ __device__ __forceinline__ int lds_byte(int r, int c) { const int st = (r >> 4) * 2 + (c >> 5), rr = r & 15, cc = c & 31, ob = rr * 64 + cc * 2; return st * 1024 + (ob ^ (((ob >> 9) & 1) << 5)); }
__host__ __device__ __forceinline__ void stage_rc(int b, int& R, int& C) { const int st = b / 1024, sb = b % 1024, swz = sb ^ (((sb >> 9) & 1) << 5); R = (st >> 1) * 16 + swz / 64; C = (st & 1) * 32 + (swz % 64) / 2; }
__host__ __device__ __forceinline__ int perm32(int rho) { const int n = rho >> 4, i = rho & 15; return 8 * (i >> 2) + 4 * n + (i & 3); }

struct Unit { int pm, pn; };
struct Gemm { const bf16_t* A; const bf16_t* Bt; int M, N, K; };

struct StaticOrder {
    int nM, nN, nwg, G, c;
    __host__ __device__ void init(int M, int N, int G_, int c_) { nM = M / BM; nN = N / BM; nwg = nM * nN; G = G_; c = c_; }
    __host__ __device__ bool next(int i, Unit& u) const {
        const long L = (long)i * G + c; if (L >= nwg) return false;
        int wgid = (int)L; { const int q = nwg / NXCD, r = nwg % NXCD, xcd = wgid % NXCD, off = wgid / NXCD; wgid = (xcd < r ? xcd * (q + 1) : r * (q + 1) + (xcd - r) * q) + off; }
        const int nig = WGM * nN, gid = wgid / nig, fm = gid * WGM, gsz = (nM - fm) < WGM ? (nM - fm) : WGM;
        u.pm = fm + ((wgid % nig) % gsz); u.pn = (wgid % nig) / gsz; return true;
    }
    __device__ __forceinline__ void a_ready(const Unit&) const {}
    __device__ __forceinline__ void done(const Unit&) const {}
};

__device__ __forceinline__ unsigned cvt_pk_bf16(float lo, float hi) { unsigned r; asm volatile("v_cvt_pk_bf16_f32 %0, %1, %2" : "=v"(r) : "v"(lo), "v"(hi)); return r; }
typedef float f32x2 __attribute__((ext_vector_type(2)));
template <int ACT  > struct EpiBf16 {
    static constexpr bool PERM = true, AFTER_DRAIN = false; static_assert(ACT == 0, "EpiBf16: ACT is 0");
    bf16_t* O; int ldc; const float* bias; int split_cols; size_t split_stride; float scale0;
    __device__ __forceinline__ void operator()(const f32x4 (&acc)[2][2][4][2], const Unit& u, int wr, int wc, int fr, int fq) const {
        const int row0 = u.pm * BM + wr * 64 + fr; int colt = u.pn * BM; bf16_t* base = O;
        float sc = 1.f; if (split_cols) { const int t = colt / split_cols; base += (size_t)t * split_stride; colt -= t * split_cols; if (t == 0) sc = scale0; }
        const int col0 = colt + wc * 32 + 8 * fq, bcol0 = u.pn * BM + wc * 32 + 8 * fq;
        f32x4 bv[2][2];
#pragma unroll
        for (int bj = 0; bj < 2; ++bj)
#pragma unroll
            for (int n = 0; n < 2; ++n) bv[bj][n] = bias ? *(const f32x4*)(bias + bcol0 + bj * HALF + 4 * n) : (f32x4){0.f, 0.f, 0.f, 0.f};
#pragma unroll
        for (int ai = 0; ai < 2; ++ai)
#pragma unroll
            for (int m = 0; m < 4; ++m) { bf16_t* rowp = base + (size_t)(row0 + ai * HALF + m * 16) * ldc + col0;
#pragma unroll
                for (int bj = 0; bj < 2; ++bj) { f32x4 v0 = acc[ai][bj][m][0] + bv[bj][0], v1 = acc[ai][bj][m][1] + bv[bj][1];
                    v0 = v0 * sc; v1 = v1 * sc; u32x4 w; w.x = cvt_pk_bf16(v0[0], v0[1]); w.y = cvt_pk_bf16(v0[2], v0[3]); w.z = cvt_pk_bf16(v1[0], v1[1]); w.w = cvt_pk_bf16(v1[2], v1[3]);
                    *(u32x4*)(rowp + bj * HALF) = w; } }
    }
};
template <class Epi, class Sched, bool ALIGN_EPI = false, bool SP2 = false>
__device__ __forceinline__ void gemm_phase(PG8_LAS unsigned char* lds, const Gemm g, const Sched& S, const Epi& E) {
    int tid_l = threadIdx.x; asm volatile("" : "+v"(tid_l));
    const int tid = tid_l, wid = __builtin_amdgcn_readfirstlane(tid >> 6), lane = tid & 63, wr = wid >> 2, wc = wid & 3, fr = lane & 15, fq = lane >> 4;
    const int K = g.K, nt = K / BK;
    unsigned voffA[2], voffB[2];
#pragma unroll
    for (int i = 0; i < 2; ++i) { int R, C; stage_rc(tid * 16 + i * 8192, R, C); const int Rb = Epi::PERM ? ((R & ~31) + perm32(R & 31)) : R;
        voffA[i] = (unsigned)(R * K + C) * 2u; voffB[i] = (unsigned)(Rb * K + C) * 2u; }
    const size_t kstep = (size_t)(BK * 2);
    const size_t hstep = (size_t)HALF * K * 2;
    const size_t tstep = 2 * hstep;
    const unsigned ldsw = (unsigned)wid * 1024u;
    const int aoff = lds_byte(wr * 64 + fr, fq * 8), boff = lds_byte(wc * 32 + fr, fq * 8);
#define PG8_SA(b, h) (((b) * 2 + (h)) * HTB)
#define PG8_SB(b, h) ((4 + (b) * 2 + (h)) * HTB)
#define PG8_STAGE(bufoff, gbase, voff) do { _Pragma("unroll") for (int _i = 0; _i < 2; ++_i) \
        __builtin_amdgcn_global_load_lds((const unsigned*)((const char*)(gbase) + (voff)[_i]), (PG8_LAS unsigned*)(lds + (bufoff) + ldsw + _i * 8192), 16, 0, 0); } while (0)
#define PG8_LDA(dst, b, h) do { _Pragma("unroll") for (int m = 0; m < 4; ++m) _Pragma("unroll") for (int k = 0; k < 2; ++k) dst[m][k] = *(const PG8_LAS bf16x8*)(lds + PG8_SA(b, h) + aoff + m * 2048 + k * 1024); } while (0)
#define PG8_LDB(dst, b, h) do { _Pragma("unroll") for (int n = 0; n < 2; ++n) _Pragma("unroll") for (int k = 0; k < 2; ++k) dst[n][k] = *(const PG8_LAS bf16x8*)(lds + PG8_SB(b, h) + boff + n * 2048 + k * 1024); } while (0)
#define PG8_MMA(ai, bj, At, Bt) do { __builtin_amdgcn_s_setprio(1); _Pragma("unroll") for (int m = 0; m < 4; ++m) _Pragma("unroll") for (int n = 0; n < 2; ++n) _Pragma("unroll") for (int k = 0; k < 2; ++k) \
        acc[ai][bj][m][n] = __builtin_amdgcn_mfma_f32_16x16x32_bf16(Bt[n][k], At[m][k], acc[ai][bj][m][n], 0, 0, 0); __builtin_amdgcn_s_setprio(0); } while (0)
#define PG8_WAIT_V(n) asm volatile("s_waitcnt vmcnt(" #n ")" ::: "memory")
#define PG8_WAIT_L(n) asm volatile("s_waitcnt lgkmcnt(" #n ")" ::: "memory")
#define PG8_BAR __builtin_amdgcn_s_barrier()
#define PG8_SCHED __builtin_amdgcn_sched_barrier(0)
    Unit cur, nxt; int ui = 0;
    if (!S.next(0, cur)) return;
    f32x4 acc[2][2][4][2];
#pragma unroll
    for (int a = 0; a < 2; ++a)
#pragma unroll
        for (int b = 0; b < 2; ++b)
#pragma unroll
            for (int m = 0; m < 4; ++m)
#pragma unroll
                for (int n = 0; n < 2; ++n) acc[a][b][m][n] = (f32x4){0.f, 0.f, 0.f, 0.f};
    bf16x8 At[4][2], B0[2][2], B1[2][2];
    const char* cA = (const char*)g.A + (size_t)cur.pm * tstep; const char* cB = (const char*)g.Bt + (size_t)cur.pn * tstep;
    S.a_ready(cur);
    if constexpr (SP2) {
        PG8_STAGE(PG8_SB(0, 0), cB, voffB); PG8_STAGE(PG8_SB(0, 1), cB + hstep, voffB); PG8_STAGE(PG8_SA(0, 0), cA, voffA); PG8_STAGE(PG8_SA(0, 1), cA + hstep, voffA);
        if (wr == 1) PG8_BAR;
        PG8_WAIT_V(2); PG8_BAR;
        PG8_STAGE(PG8_SB(1, 0), cB + kstep, voffB); PG8_STAGE(PG8_SA(1, 0), cA + kstep, voffA); PG8_STAGE(PG8_SB(1, 1), cB + hstep + kstep, voffB);
        PG8_WAIT_V(6); PG8_BAR;
    } else {
        PG8_STAGE(PG8_SB(0, 0), cB, voffB); PG8_STAGE(PG8_SA(0, 0), cA, voffA); PG8_STAGE(PG8_SB(0, 1), cB + hstep, voffB); PG8_STAGE(PG8_SA(0, 1), cA + hstep, voffA);
        if (wr == 1) PG8_BAR;
        PG8_WAIT_V(4); PG8_BAR;
        PG8_STAGE(PG8_SB(1, 0), cB + kstep, voffB); PG8_STAGE(PG8_SA(1, 0), cA + kstep, voffA); PG8_STAGE(PG8_SB(1, 1), cB + hstep + kstep, voffB);
        PG8_WAIT_V(6); PG8_BAR;
    }
    for (;;) {
        const bool has_next = S.next(ui + 1, nxt);
        const char* nA = has_next ? (const char*)g.A + (size_t)nxt.pm * tstep : cA; const char* nB = has_next ? (const char*)g.Bt + (size_t)nxt.pn * tstep : cB;
        for (int t = 0; t < nt; t += 2) {
            const bool last = (t == nt - 2);
            const char* a1 = cA + (size_t)(t + 1) * kstep;
            const char* a2 = last ? nA : cA + (size_t)(t + 2) * kstep; const char* b2 = last ? nB : cB + (size_t)(t + 2) * kstep;
            const char* a3 = a2 + kstep; const char* b3 = b2 + kstep;
            if (last && has_next) S.a_ready(nxt);
            if constexpr (SP2) {
            PG8_LDB(B0, 0, 0); PG8_LDB(B1, 0, 1); PG8_SCHED; PG8_LDA(At, 0, 0); PG8_STAGE(PG8_SA(1, 1), a1 + hstep, voffA);
            PG8_WAIT_V(8); PG8_WAIT_L(0); PG8_BAR; PG8_MMA(0, 0, At, B0); PG8_MMA(0, 1, At, B1); PG8_BAR; PG8_SCHED;
            PG8_LDA(At, 0, 1); PG8_STAGE(PG8_SB(0, 0), b2, voffB); PG8_STAGE(PG8_SB(0, 1), b2 + hstep, voffB); PG8_STAGE(PG8_SA(0, 0), a2, voffA);
            PG8_WAIT_V(8); PG8_WAIT_L(0); PG8_BAR; PG8_MMA(1, 0, At, B0); PG8_MMA(1, 1, At, B1); PG8_BAR; PG8_SCHED;
            PG8_LDB(B0, 1, 0); PG8_LDB(B1, 1, 1); PG8_SCHED; PG8_LDA(At, 1, 0); PG8_STAGE(PG8_SA(0, 1), a2 + hstep, voffA);
            PG8_WAIT_V(8); PG8_WAIT_L(0); PG8_BAR; PG8_MMA(0, 0, At, B0); PG8_MMA(0, 1, At, B1); PG8_BAR; PG8_SCHED;
            PG8_LDA(At, 1, 1); PG8_STAGE(PG8_SB(1, 0), b3, voffB); PG8_STAGE(PG8_SB(1, 1), b3 + hstep, voffB); PG8_STAGE(PG8_SA(1, 0), a3, voffA);
            PG8_WAIT_V(8); PG8_WAIT_L(0); PG8_BAR; PG8_MMA(1, 0, At, B0); PG8_MMA(1, 1, At, B1); PG8_BAR; PG8_SCHED;
            } else {
            PG8_LDB(B0, 0, 0); PG8_SCHED; PG8_LDA(At, 0, 0); PG8_STAGE(PG8_SA(1, 1), a1 + hstep, voffA);
            PG8_WAIT_L(8); PG8_BAR; PG8_WAIT_L(0); PG8_MMA(0, 0, At, B0); PG8_BAR; PG8_SCHED;
            PG8_LDB(B1, 0, 1); PG8_STAGE(PG8_SB(0, 0), b2, voffB);
            PG8_BAR; PG8_WAIT_L(0); PG8_MMA(0, 1, At, B1); PG8_BAR;
            PG8_LDA(At, 0, 1); PG8_STAGE(PG8_SA(0, 0), a2, voffA);
            PG8_BAR; PG8_WAIT_L(0); PG8_MMA(1, 0, At, B0); PG8_BAR; PG8_SCHED;
            PG8_STAGE(PG8_SB(0, 1), b2 + hstep, voffB);
            PG8_WAIT_V(6); PG8_BAR; PG8_MMA(1, 1, At, B1); PG8_BAR;
            PG8_LDB(B0, 1, 0); PG8_SCHED; PG8_LDA(At, 1, 0); PG8_STAGE(PG8_SA(0, 1), a2 + hstep, voffA);
            PG8_WAIT_L(8); PG8_BAR; PG8_WAIT_L(0); PG8_MMA(0, 0, At, B0); PG8_BAR; PG8_SCHED;
            PG8_LDB(B1, 1, 1); PG8_STAGE(PG8_SB(1, 0), b3, voffB);
            PG8_BAR; PG8_WAIT_L(0); PG8_MMA(0, 1, At, B1); PG8_BAR;
            PG8_LDA(At, 1, 1); PG8_STAGE(PG8_SA(1, 0), a3, voffA);
            PG8_BAR; PG8_WAIT_L(0); PG8_MMA(1, 0, At, B0); PG8_BAR; PG8_SCHED;
            PG8_STAGE(PG8_SB(1, 1), b3 + hstep, voffB);
            PG8_WAIT_V(6); PG8_BAR; PG8_MMA(1, 1, At, B1); PG8_BAR;
            }
        }
        if constexpr (ALIGN_EPI) { if (wr == 0) PG8_BAR; }
        if constexpr (!Epi::AFTER_DRAIN) { E(acc, cur, wr, wc, fr, fq); S.done(cur); }
        if (!has_next) break;
#pragma unroll
        for (int a = 0; a < 2; ++a)
#pragma unroll
            for (int b = 0; b < 2; ++b)
#pragma unroll
                for (int m = 0; m < 4; ++m)
#pragma unroll
                    for (int n = 0; n < 2; ++n) acc[a][b][m][n] = (f32x4){0.f, 0.f, 0.f, 0.f};
        cur = nxt; cA = nA; cB = nB; ++ui;
        if constexpr (ALIGN_EPI) { if (wr == 1) PG8_BAR; }
    }
    PG8_WAIT_V(0);
    if constexpr (!ALIGN_EPI) { if (wr == 0) PG8_BAR; }
    PG8_BAR;
    if constexpr (Epi::AFTER_DRAIN) { E.fused(acc, cur, wr, wc, fr, fq, lds, wid, lane); S.done(cur); }
#undef PG8_SA
#undef PG8_SB
#undef PG8_STAGE
#undef PG8_LDA
#undef PG8_LDB
#undef PG8_MMA
#undef PG8_WAIT_V
#undef PG8_WAIT_L
#undef PG8_BAR
#undef PG8_SCHED
}
}
#include <hip/hip_bf16.h>
#include <cmath>
namespace attn_body {
using bf16=__hip_bfloat16;
using bf16x8=__attribute__((ext_vector_type(8)))short;
using s16x4=__attribute__((ext_vector_type(4)))short;
using f32x16=__attribute__((ext_vector_type(16)))float;
using u32x4=__attribute__((ext_vector_type(4)))unsigned;
using f32x4_t=__attribute__((ext_vector_type(4)))float;
constexpr int D=64,PQ=2304,PO=1024;
constexpr int NW=8,QBLK=32,QB=QBLK*NW,KVBLK=64;
__device__ __forceinline__ int crow(int r,int hi){return (r&3)+8*(r>>2)+4*hi;}
#define SBAR() __builtin_amdgcn_sched_barrier(0)
__device__ __forceinline__ void cmask(f32x16&p0,f32x16&p1,int jb,int qrel,int hi){
  const float NEG=-INFINITY; int kb=64*jb+4*hi;
  #pragma unroll
  for(int r=0;r<16;++r){int kv=kb+(r&3)+8*(r>>2); if(kv>qrel)p0[r]=NEG; if(kv+32>qrel)p1[r]=NEG;}
}

constexpr int NSLOT=3, SLOTB=8192;
constexpr int LDS_K=0, LDS_V=NSLOT*SLOTB, LDS_WS=2*NSLOT*SLOTB, LDS_OST=LDS_WS+NW*64*4, LDS_BYTES=LDS_OST+NW*4096;
constexpr float C2=0.125f*1.4426950408889634f;
__device__ __forceinline__ void glds16(const void*gsrc,unsigned lds_dst){unsigned keep;
  asm volatile("s_mov_b32 %0, m0\n\ts_mov_b32 m0, %2\n\ts_nop 0\n\tglobal_load_lds_dwordx4 %1, off\n\ts_mov_b32 m0, %0":"=&s"(keep):"v"(gsrc),"s"(lds_dst):"memory");}
__device__ __forceinline__ float max3f(float a,float b,float c){float r;asm("v_max3_f32 %0, %1, %2, %3":"=v"(r):"v"(a),"v"(b),"v"(c));return r;}
__device__ __forceinline__ float max2f(float a,float b){float r;asm("v_max_f32_e32 %0, %1, %2":"=v"(r):"v"(a),"v"(b));return r;}
__device__ __forceinline__ float fadd_s(float a,float b){float r;asm("v_add_f32_e32 %0, %1, %2":"=v"(r):"v"(a),"v"(b));return r;}
__device__ __forceinline__ float fsub_s(float a,float b){float r;asm("v_sub_f32_e32 %0, %1, %2":"=v"(r):"v"(a),"v"(b));return r;}
typedef float f32x2_t __attribute__((ext_vector_type(2))); typedef __bf16 bf16x2_t __attribute__((ext_vector_type(2)));
__device__ __forceinline__ unsigned cvtpk_s(float lo,float hi){f32x2_t v={lo,hi};bf16x2_t b=__builtin_convertvector(v,bf16x2_t);return __builtin_bit_cast(unsigned,b);}
#define WAIT_BAR(N) asm volatile("s_waitcnt vmcnt(" #N ") lgkmcnt(0)\n\ts_barrier":::"memory")

__device__ __forceinline__ void qkt(f32x16&p0,f32x16&p1,const char*Kslot,const bf16x8*qr,const f32x16&negm,int r32,int hi){
  const char*kb=Kslot+hi*1024+r32*16;
  #pragma unroll
  for(int d0=0;d0<4;++d0){
    const bf16x8 b0=*reinterpret_cast<const bf16x8*>(kb+d0*2048);
    const bf16x8 b1=*reinterpret_cast<const bf16x8*>(kb+d0*2048+512);
    if(d0==0){p0=__builtin_amdgcn_mfma_f32_32x32x16_bf16(b0,qr[0],negm,0,0,0);p1=__builtin_amdgcn_mfma_f32_32x32x16_bf16(b1,qr[0],negm,0,0,0);}
    else{p0=__builtin_amdgcn_mfma_f32_32x32x16_bf16(b0,qr[d0],p0,0,0,0);p1=__builtin_amdgcn_mfma_f32_32x32x16_bf16(b1,qr[d0],p1,0,0,0);}}
}
typedef __attribute__((address_space(3))) const char* lds_cptr;
typedef short v4i16_t __attribute__((ext_vector_type(4)));
__device__ __forceinline__ void kload8(bf16x8*kf,lds_cptr kp){
  kf[0]=*(const __attribute__((address_space(3))) bf16x8*)(kp);      kf[1]=*(const __attribute__((address_space(3))) bf16x8*)(kp+512);
  kf[2]=*(const __attribute__((address_space(3))) bf16x8*)(kp+2048); kf[3]=*(const __attribute__((address_space(3))) bf16x8*)(kp+2560);
  kf[4]=*(const __attribute__((address_space(3))) bf16x8*)(kp+4096); kf[5]=*(const __attribute__((address_space(3))) bf16x8*)(kp+4608);
  kf[6]=*(const __attribute__((address_space(3))) bf16x8*)(kp+6144); kf[7]=*(const __attribute__((address_space(3))) bf16x8*)(kp+6656);
}
__device__ __forceinline__ void kload2(bf16x8*kf,lds_cptr kp,int j){ kf[2*j]=*(const __attribute__((address_space(3))) bf16x8*)(kp+j*2048); kf[2*j+1]=*(const __attribute__((address_space(3))) bf16x8*)(kp+j*2048+512); }
__device__ __forceinline__ s16x4 vtr(lds_cptr p){ return __builtin_bit_cast(s16x4,__builtin_amdgcn_ds_read_tr16_b64_v4i16((__attribute__((address_space(3))) v4i16_t*)p)); }
__device__ __forceinline__ float rowmax(const f32x16&p0,const f32x16&p1){
  float a=max3f(p0[0],p0[1],p1[0]),b=max3f(p0[2],p0[3],p1[1]);a=max3f(a,p1[2],p1[3]);
  #pragma unroll
  for(int r=4;r<16;r+=4){a=max3f(a,p0[r],p0[r+1]);b=max3f(b,p0[r+2],p0[r+3]);a=max3f(a,p1[r],p1[r+1]);b=max3f(b,p1[r+2],p1[r+3]);}
  const float m=max2f(a,b);
  auto rr=__builtin_amdgcn_permlane32_swap(__float_as_uint(m),__float_as_uint(m),false,false);
  return max2f(__uint_as_float(rr[0]),__uint_as_float(rr[1]));
}
__device__ __forceinline__ void pv(f32x16*o,int vb,bf16x8 pa0,bf16x8 pa1,bf16x8 pa2,bf16x8 pa3){
  #pragma unroll
  for(int d0=0;d0<2;++d0){s16x4 lo[4],hi[4];
    #pragma unroll
    for(int ks=0;ks<4;++ks){
      asm volatile("ds_read_b64_tr_b16 %0,%1 offset:%c2":"=&v"(lo[ks]):"v"(vb),"i"(d0*4096+ks*1024):"memory");
      asm volatile("ds_read_b64_tr_b16 %0,%1 offset:%c2":"=&v"(hi[ks]):"v"(vb),"i"(d0*4096+ks*1024+512):"memory");}
    asm volatile("s_waitcnt lgkmcnt(0)":::"memory");SBAR();
    #define PK(k) (bf16x8){lo[k][0],lo[k][1],lo[k][2],lo[k][3],hi[k][0],hi[k][1],hi[k][2],hi[k][3]}
    o[d0]=__builtin_amdgcn_mfma_f32_32x32x16_bf16(pa0,PK(0),o[d0],0,0,0);
    o[d0]=__builtin_amdgcn_mfma_f32_32x32x16_bf16(pa1,PK(1),o[d0],0,0,0);
    o[d0]=__builtin_amdgcn_mfma_f32_32x32x16_bf16(pa2,PK(2),o[d0],0,0,0);
    o[d0]=__builtin_amdgcn_mfma_f32_32x32x16_bf16(pa3,PK(3),o[d0],0,0,0);
    #undef PK
  }
}

#ifndef ATTN_STORE16
#define ATTN_STORE16(p,v) (*(u32x4*)(p)=(v))
#endif
template<int THRL> __device__ __forceinline__ void attn_unit(long rowbase,int NT,int q0,const bf16*Qh,const bf16*Kc,const bf16*Vc,bf16*Oh,char*shm,const float*rope,const float*qn){
  int tid_l=threadIdx.x; asm volatile("":"+v"(tid_l)); const int tid=tid_l,lane=tid&63,r32=lane&31,hi=lane>>5; const int wid=__builtin_amdgcn_readfirstlane(tid>>6);
  const bf16*Qw=Qh+(rowbase+q0+wid*QBLK)*PQ;
  const bf16*Kh=Kc+rowbase*PQ,*Vh=Vc+rowbase*PQ;
  const unsigned lds0=(unsigned)(uintptr_t)shm;
  float*wsf=(float*)(shm+LDS_WS)+wid*64;
  const bf16*ksrc=Kh+(long)lane*PQ+wid*8;
  const bf16*vsrc=Vh+(long)(16*(wid&3)+(lane>>2))*PQ+(wid>>2)*32+(lane&3)*8;
  const unsigned kdst=lds0+LDS_K+wid*1024, vdst=lds0+LDS_V+wid*1024;
  #define DMA_K(t,slot) glds16(ksrc+(long)(t)*KVBLK*PQ,(unsigned)__builtin_amdgcn_readfirstlane(kdst+(slot)))
  #define DMA_V(t,slot) glds16(vsrc+(long)(t)*KVBLK*PQ,(unsigned)__builtin_amdgcn_readfirstlane(vdst+(slot)))
  const int vb0=(int)(lds0+LDS_V)+((lane>>4)&1)*32+(lane&3)*8+(4*hi+((lane&15)>>2))*64;
  const char*Kbase=shm+LDS_K; bf16x8 kf[8];
  const lds_cptr shm3=(lds_cptr)shm; const lds_cptr kp0=shm3+LDS_K+hi*1024+r32*16; const lds_cptr vp0=shm3+LDS_V+((lane>>4)&1)*32+(lane&3)*8+(4*hi+((lane&15)>>2))*64;
  DMA_K(0,0);DMA_V(0,0);DMA_K(1,SLOTB);
  bf16x8 qr[4];
  #pragma unroll
  for(int d0=0;d0<4;++d0)qr[d0]=*reinterpret_cast<const bf16x8*>(&Qw[(long)r32*PQ+d0*16+hi*8]);
  { float qf[4][8]; float ss=0.f;
    #pragma unroll
    for(int d0=0;d0<4;++d0){
      #pragma unroll
      for(int i=0;i<8;++i){ qf[d0][i]=__uint_as_float(((unsigned)(unsigned short)qr[d0][i])<<16); ss+=qf[d0][i]*qf[d0][i]; } }
    { auto rr=__builtin_amdgcn_permlane32_swap(__float_as_uint(ss),__float_as_uint(ss),false,false); ss=__uint_as_float(rr[0])+__uint_as_float(rr[1]); }
    const float rn=1.f/sqrtf(ss*(1.f/64.f)+1e-6f);
    const float*rp=rope+((long)(q0+wid*QBLK+r32)*32+hi*4)*2;
    #pragma unroll
    for(int d0=0;d0<4;++d0){
      const f32x4_t c01=*reinterpret_cast<const f32x4_t*>(rp+d0*16), c23=*reinterpret_cast<const f32x4_t*>(rp+d0*16+4);
      const f32x4_t g03=*reinterpret_cast<const f32x4_t*>(qn+d0*16+hi*8), g47=*reinterpret_cast<const f32x4_t*>(qn+d0*16+hi*8+4);
      const float cs_[4]={c01[0],c01[2],c23[0],c23[2]}, sn_[4]={c01[1],c01[3],c23[1],c23[3]}, gg[8]={g03[0],g03[1],g03[2],g03[3],g47[0],g47[1],g47[2],g47[3]};
      unsigned w[4];
      #pragma unroll
      for(int j=0;j<4;++j){ const float y0=qf[d0][2*j]*rn*gg[2*j], y1=qf[d0][2*j+1]*rn*gg[2*j+1];
        w[j]=cvtpk_s((y0*cs_[j]-y1*sn_[j])*C2,(y0*sn_[j]+y1*cs_[j])*C2); }
      qr[d0]=__builtin_bit_cast(bf16x8,(u32x4){w[0],w[1],w[2],w[3]}); } }
  float mhat=0.f,l_reg=0.f;f32x16 o[2];f32x16 negm;
  { float zz=0.f; asm volatile("":"+v"(zz));
    _Pragma("unroll") for(int r=0;r<16;++r){o[0][r]=zz;o[1][r]=zz;negm[r]=zz;} }
  asm volatile("":"+v"(negm));
  #define CMASK(P0,P1,t) do{}while(0)
  bool resc=false;
  #define START(P0,P1) do{ const float rm=rowmax(P0,P1); resc=false; \
    { const float dl=rm; mhat=fadd_s(mhat,dl); \
      _Pragma("unroll") for(int r=0;r<16;++r){P0[r]=fsub_s(P0[r],dl);P1[r]=fsub_s(P1[r],dl);} \
      _Pragma("unroll") for(int r=0;r<16;++r)negm[r]=-mhat; asm volatile("":"+v"(negm)); } \
    _Pragma("unroll") for(int r=0;r<16;++r)P0[r]=__builtin_amdgcn_exp2f(P0[r]); }while(0)
  #define RESC() do{ if(resc){ asm volatile("s_waitcnt lgkmcnt(0)":::"memory"); \
      _Pragma("unroll") for(int d_=0;d_<2;++d_) _Pragma("unroll") for(int r=0;r<16;++r)o[d_][r]*=wsf[crow(r,hi)]; } }while(0)
  f32x16 pA0,pA1,pB0,pB1;
  int sl_prev=0,sl_cur=0,sl_next=SLOTB;
  #define ROT() do{sl_prev=sl_cur;sl_cur=sl_next;sl_next=(sl_next==(NSLOT-1)*SLOTB)?0:sl_next+SLOTB;}while(0)
  DMA_K(2,2*SLOTB);
  WAIT_BAR(3);
  qkt(pA0,pA1,Kbase,qr,negm,r32,hi);asm volatile("s_nop 15\n\ts_nop 7":"+v"(pA0),"+v"(pA1));CMASK(pA0,pA1,0);
  START(pA0,pA1);
  _Pragma("unroll") for(int r=0;r<16;++r)pA1[r]=__builtin_amdgcn_exp2f(pA1[r]);
  WAIT_BAR(0);
  DMA_K(3,0);DMA_V(1,SLOTB);
  ROT();
  kload8(kf,kp0+sl_cur);
  WAIT_BAR(2);
  s16x4 vlo[8],vhi[8]; u32x4 pw0,pw1,pw2,pw3;
  #define PKW(P,B) cvtpk_s(P[B],P[B+1])
  #define PAF(k) __builtin_bit_cast(bf16x8,pw##k)
  #define VFR(i) (bf16x8){vlo[i][0],vlo[i][1],vlo[i][2],vlo[i][3],vhi[i][0],vhi[i][1],vhi[i][2],vhi[i][3]}
  #define PIN(x) asm volatile("":"+v"(x))
  #define MX3(a,b,c) __builtin_fmaxf(__builtin_fmaxf((a),(b)),(c))
  #define GAPA(MF,A0,A1,A2,A3,W0,W1,PW) do{ MF; sacc+=A0; sacc+=A1; sacc+=A2; sacc+=A3; PIN(sacc); W0; W1; PIN(PW); SBAR(); }while(0)
  #define EX(v) __builtin_amdgcn_exp2f(v)
  #define GAPB(MF,X,B) do{ MF; X[B]=EX(X[B]); X[B+1]=EX(X[B+1]); X[B+2]=EX(X[B+2]); X[B+3]=EX(X[B+3]); PIN(X); SBAR(); }while(0)
  #define VRD(i) do{ vlo[i]=vtr(vp_+(((i)>>2)*4096+((i)&3)*1024)); vhi[i]=vtr(vp_+(((i)>>2)*4096+((i)&3)*1024+512)); }while(0)
  #define KRD(G,j) do{ if(G){ kload2(kf,kp0+sl_next,j); SBAR(); } }while(0)
  #define STEP(C0,C1,P0,P1,t,GK,GV,GL) do{ SBAR(); \
    const lds_cptr vp_=vp0+sl_prev; \
    VRD(0); SBAR(); float sacc=(P0[0]+P0[1]); \
    GAPA(C0=__builtin_amdgcn_mfma_f32_32x32x16_bf16(kf[0],qr[0],negm,0,0,0), P0[2],P0[3],P0[4],P0[5],     pw0[0]=PKW(P0,0), pw0[1]=PKW(P0,2), pw0); \
    VRD(4); SBAR(); GAPA(C1=__builtin_amdgcn_mfma_f32_32x32x16_bf16(kf[1],qr[0],negm,0,0,0), P0[6],P0[7],P0[8],P0[9],     pw0[2]=PKW(P0,4), pw0[3]=PKW(P0,6), pw0); \
    VRD(1); SBAR(); GAPA(C0=__builtin_amdgcn_mfma_f32_32x32x16_bf16(kf[2],qr[1],C0,0,0,0),   P0[10],P0[11],P0[12],P0[13], pw1[0]=PKW(P0,8), pw1[1]=PKW(P0,10), pw1); \
    VRD(5); SBAR(); GAPA(C1=__builtin_amdgcn_mfma_f32_32x32x16_bf16(kf[3],qr[1],C1,0,0,0),   P0[14],P0[15],P1[0],P1[1],   pw1[2]=PKW(P0,12),pw1[3]=PKW(P0,14), pw1); \
    VRD(2); SBAR(); GAPA(C0=__builtin_amdgcn_mfma_f32_32x32x16_bf16(kf[4],qr[2],C0,0,0,0),   P1[2],P1[3],P1[4],P1[5],     pw2[0]=PKW(P1,0), pw2[1]=PKW(P1,2), pw2); \
    VRD(6); SBAR(); GAPA(C1=__builtin_amdgcn_mfma_f32_32x32x16_bf16(kf[5],qr[2],C1,0,0,0),   P1[6],P1[7],P1[8],P1[9],     pw2[2]=PKW(P1,4), pw2[3]=PKW(P1,6), pw2); \
    VRD(3); SBAR(); GAPA(C0=__builtin_amdgcn_mfma_f32_32x32x16_bf16(kf[6],qr[3],C0,0,0,0),   P1[10],P1[11],P1[12],P1[13], pw3[0]=PKW(P1,8), pw3[1]=PKW(P1,10), pw3); \
    VRD(7); SBAR(); GAPA(C1=__builtin_amdgcn_mfma_f32_32x32x16_bf16(kf[7],qr[3],C1,0,0,0),   P1[14],P1[15],0.f,0.f,       pw3[2]=PKW(P1,12),pw3[3]=PKW(P1,14), pw3); \
    l_reg+=sacc; \
    if(GK){DMA_K((t)+3,sl_cur);} if(GV){DMA_V((t)+1,sl_next);} \
    CMASK(C0,C1,t); \
    { float a=MX3(C0[0],C0[1],C1[0]),b=MX3(C0[2],C0[3],C1[1]); a=MX3(a,C1[2],C1[3]); \
      _Pragma("unroll") for(int r=4;r<16;r+=4){a=MX3(a,C0[r],C0[r+1]);b=MX3(b,C0[r+2],C0[r+3]);a=MX3(a,C1[r],C1[r+1]);b=MX3(b,C1[r+2],C1[r+3]);} \
      float rm=__builtin_fmaxf(a,b); { auto rr=__builtin_amdgcn_permlane32_swap(__float_as_uint(rm),__float_as_uint(rm),false,false); rm=__builtin_fmaxf(__uint_as_float(rr[0]),__uint_as_float(rr[1])); } \
      resc=false; \
      if(__builtin_expect(__any(rm>(float)THRL),0)){ const float dl=__builtin_fmaxf(rm,0.f); mhat+=dl; \
        _Pragma("unroll") for(int r=0;r<16;++r){C0[r]-=dl;C1[r]-=dl;} \
        _Pragma("unroll") for(int r=0;r<16;++r)negm[r]=-mhat; asm volatile("":"+v"(negm)); \
        const float f=__builtin_amdgcn_exp2f(-dl); l_reg*=f; if(hi==0)wsf[r32]=f; resc=true; } } \
    SBAR(); \
    GAPB(o[0]=__builtin_amdgcn_mfma_f32_32x32x16_bf16(PAF(0),VFR(0),o[0],0,0,0), C0,0); \
    GAPB(o[1]=__builtin_amdgcn_mfma_f32_32x32x16_bf16(PAF(0),VFR(4),o[1],0,0,0), C0,4); \
    KRD(GL,0); GAPB(o[0]=__builtin_amdgcn_mfma_f32_32x32x16_bf16(PAF(1),VFR(1),o[0],0,0,0), C0,8); \
    KRD(GL,1); GAPB(o[1]=__builtin_amdgcn_mfma_f32_32x32x16_bf16(PAF(1),VFR(5),o[1],0,0,0), C0,12); \
    KRD(GL,2); GAPB(o[0]=__builtin_amdgcn_mfma_f32_32x32x16_bf16(PAF(2),VFR(2),o[0],0,0,0), C1,0); \
    KRD(GL,3); GAPB(o[1]=__builtin_amdgcn_mfma_f32_32x32x16_bf16(PAF(2),VFR(6),o[1],0,0,0), C1,4); \
    GAPB(o[0]=__builtin_amdgcn_mfma_f32_32x32x16_bf16(PAF(3),VFR(3),o[0],0,0,0), C1,8); \
    GAPB(o[1]=__builtin_amdgcn_mfma_f32_32x32x16_bf16(PAF(3),VFR(7),o[1],0,0,0), C1,12); \
    }while(0)
  int t=1;
  for(;t+5<NT;t+=2){
    STEP(pB0,pB1,pA0,pA1,t,true,true,true);     WAIT_BAR(2); RESC(); ROT();
    STEP(pA0,pA1,pB0,pB1,t+1,true,true,true);   WAIT_BAR(2); RESC(); ROT();
  }
  #define ENDW(tt) do{ if((tt)+3<NT){WAIT_BAR(2);} else if((tt)+2<NT){WAIT_BAR(1);} else {WAIT_BAR(0);} }while(0)
  for(;t+1<NT;t+=2){
    STEP(pB0,pB1,pA0,pA1,t,(t+3<NT),(t+1<NT),(t+1<NT));       ENDW(t);   RESC(); ROT();
    STEP(pA0,pA1,pB0,pB1,t+1,(t+4<NT),(t+2<NT),(t+2<NT));     ENDW(t+1); RESC(); ROT();
  }
  STEP(pB0,pB1,pA0,pA1,NT-1,false,false,false); RESC();
  { float sacc=pB0[0]+pB0[1]; _Pragma("unroll") for(int r=2;r<16;++r)sacc+=pB0[r]; _Pragma("unroll") for(int r=0;r<16;++r)sacc+=pB1[r]; l_reg+=sacc;
    pw0=(u32x4){PKW(pB0,0),PKW(pB0,2),PKW(pB0,4),PKW(pB0,6)};pw1=(u32x4){PKW(pB0,8),PKW(pB0,10),PKW(pB0,12),PKW(pB0,14)};pw2=(u32x4){PKW(pB1,0),PKW(pB1,2),PKW(pB1,4),PKW(pB1,6)};pw3=(u32x4){PKW(pB1,8),PKW(pB1,10),PKW(pB1,12),PKW(pB1,14)};
    SBAR(); pv(o,vb0+sl_cur,PAF(0),PAF(1),PAF(2),PAF(3)); }
  #undef PKW
  #undef PAF
  #undef VFR
  #undef PIN
  #undef MX3
  #undef GAPA
  #undef GAPB
  #undef EX
  #undef VRD
  #undef KRD
  #undef STEP
  #undef ENDW
  {auto rr=__builtin_amdgcn_permlane32_swap(__float_as_uint(l_reg),__float_as_uint(l_reg),false,false);l_reg=__uint_as_float(rr[0])+__uint_as_float(rr[1]);}
  if(hi==0)wsf[32+r32]=l_reg;asm volatile("s_waitcnt lgkmcnt(0)":::"memory");
  float rli[16];
  #pragma unroll
  for(int r=0;r<16;++r)rli[r]=__builtin_amdgcn_rcpf(wsf[32+crow(r,hi)]);
  bf16*Ow=Oh+(rowbase+q0+wid*QBLK)*PO;
  { bf16*stg=(bf16*)(shm+LDS_OST)+wid*2048;
    #pragma unroll
    for(int r=0;r<16;++r){const int orow=crow(r,hi);
      #pragma unroll
      for(int d0=0;d0<2;++d0)stg[orow*64+d0*32+r32]=__float2bfloat16(o[d0][r]*rli[r]);}
    asm volatile("s_waitcnt lgkmcnt(0)":::"memory");
    #pragma unroll
    for(int i=0;i<4;++i){const int row=i*8+(lane>>3),ch=lane&7; const u32x4 v=*(const u32x4*)(stg+row*64+ch*8); ATTN_STORE16(Ow+(long)row*PO+ch*8,v);} }
  asm volatile("s_waitcnt lgkmcnt(0)\n\ts_barrier":::"memory");
  #undef DMA_K
  #undef DMA_V
  #undef CMASK
  #undef START
  #undef RESC
  #undef ROT
}
constexpr int ATTN_LDS_BYTES=LDS_BYTES;
#undef SBAR
#undef WAIT_BAR
}
namespace mk {
typedef unsigned short bf16_t;
typedef unsigned u32x4 __attribute__((ext_vector_type(4)));
typedef float f32x4 __attribute__((ext_vector_type(4)));
typedef float f2v __attribute__((ext_vector_type(2)));
#define LAS __attribute__((address_space(3)))
constexpr int DM = 1024, MTOK = 65536, MHALF = 32768, INW = 2304, DFF = 2816, UPW = 5632, NLAYER = 4;
constexpr float ALPHA = 1.6817928305074290f, LN_EPS = 1e-6f;
constexpr size_t MiB = 1u << 20;
constexpr size_t WS_ROPE = 1 * MiB, WS_W = 4 * MiB, W_LAYER = 23 * MiB, W_IN = 0, W_O = 4608 * 1024, W_UP = 6656 * 1024, W_DOWN = 17920 * 1024;
constexpr size_t WS_XBF = 96 * MiB, WS_Z = 224 * MiB, WS_MIX = 512 * MiB, WS_H = 224 * MiB  , WS_EDGE = 640 * MiB, WS_SPA = 664 * MiB, WS_SPB = 672 * MiB  ,
                 WS_CDIN = 680 * MiB  , WS_CDUP = 681 * MiB  , WS_PIN = 682 * MiB  , WS_PUP = 684 * MiB  , WS_ONES = 688 * MiB, WS_EDGE2 = 689 * MiB  , WS_BAR = 0  , WS_END = 692 * MiB;
constexpr int BARST_OFF = 131072;
constexpr int ST_OFF = 131072 + 1024 + 8192;
constexpr int HALO_OFF = 131072 + 1024;
constexpr int LDS_BYTES = 147456;

__device__ __forceinline__ float bf2f(unsigned b) { return __uint_as_float(b << 16); }
__device__ __forceinline__ unsigned pk(float lo, float hi) { return pg8::cvt_pk_bf16(lo, hi); }
__device__ __forceinline__ void unpack8(u32x4 w, float* f) { f[0] = bf2f(w.x & 0xffffu); f[1] = bf2f(w.x >> 16); f[2] = bf2f(w.y & 0xffffu); f[3] = bf2f(w.y >> 16);
    f[4] = bf2f(w.z & 0xffffu); f[5] = bf2f(w.z >> 16); f[6] = bf2f(w.w & 0xffffu); f[7] = bf2f(w.w >> 16); }
template <int O> __device__ __forceinline__ float swz_xor(float v) { return __int_as_float(__builtin_amdgcn_ds_swizzle(__float_as_int(v), (O << 10) | 0x1f)); }
__device__ __forceinline__ float half_sum(float v) { v += swz_xor<1>(v); v += swz_xor<2>(v); v += swz_xor<4>(v); v += swz_xor<8>(v); v += swz_xor<16>(v); return v; }
__device__ __forceinline__ float wave_sum(float v) { v = half_sum(v); auto rr = __builtin_amdgcn_permlane32_swap(__float_as_uint(v), __float_as_uint(v), false, false); return __uint_as_float(rr[0]) + __uint_as_float(rr[1]); }
__device__ __forceinline__ void transpose_item(const float* W, int K, int N, bf16_t* WT, int pbase, int phalf, const float* gvec, const float* bvec, float2* PART, LAS float* scr, int item, int lane) {
    const int nblk = N / 32, kb = item / nblk, nb = item % nblk, k0 = 64 * kb, n0 = 32 * nb;
    int d0 = n0;
    if (phalf && n0 >= pbase) { const int v = (n0 - pbase) >= phalf ? 1 : 0, nn = n0 - pbase - v * phalf; d0 = pbase + 256 * (nn / 128) + 128 * v + (nn % 128); }
#pragma unroll 8
    for (int i = 0; i < 32; ++i) { const int kk = 2 * i + (lane >> 5); scr[kk * 33 + (lane & 31)] = W[(size_t)(k0 + kk) * N + n0 + (lane & 31)]; }
    asm volatile("s_waitcnt lgkmcnt(0)" ::: "memory");
    const int c = lane & 7;
    float gk[8], bk[8];
#pragma unroll
    for (int q = 0; q < 8; ++q) { gk[q] = gvec ? gvec[k0 + 8 * c + q] : 1.f; bk[q] = gvec ? bvec[k0 + 8 * c + q] : 0.f; }
#pragma unroll
    for (int j = 0; j < 4; ++j) { const int n = (lane >> 3) + 8 * j; const LAS float* sp = scr + (8 * c) * 33 + n;
        float w[8]; float ds = 0.f;
#pragma unroll
        for (int q = 0; q < 8; ++q) { const float x = sp[q * 33]; ds += bk[q] * x; w[q] = gk[q] * x; }
        u32x4 o; o.x = pk(w[0], w[1]); o.y = pk(w[2], w[3]); o.z = pk(w[4], w[5]); o.w = pk(w[6], w[7]);
        *(u32x4*)(WT + (size_t)(d0 + n) * K + k0 + 8 * c) = o;
        if (PART) {
            float cs = ((bf2f(o.x & 0xffffu) + bf2f(o.x >> 16)) + (bf2f(o.y & 0xffffu) + bf2f(o.y >> 16))) + ((bf2f(o.z & 0xffffu) + bf2f(o.z >> 16)) + (bf2f(o.w & 0xffffu) + bf2f(o.w >> 16)));
            cs += swz_xor<1>(cs); cs += swz_xor<2>(cs); cs += swz_xor<4>(cs); ds += swz_xor<1>(ds); ds += swz_xor<2>(ds); ds += swz_xor<4>(ds);
            if (c == 0) PART[(size_t)kb * N + d0 + n] = make_float2(cs, ds);
        }
    }
    asm volatile("s_waitcnt lgkmcnt(0)" ::: "memory");
}
template <bool NORM, bool WF32 = true, bool WB16 = true> __device__ __forceinline__ void row_pass(const float* src, float* dstf, bf16_t* dstb, const float* g, const float* b, int lane) {
    const f32x4* xr = (const f32x4*)src + lane;
    f32x4 v[4]; float s = 0.f;
#pragma unroll
    for (int j = 0; j < 4; ++j) { v[j] = xr[64 * j]; s += (v[j].x + v[j].y) + (v[j].z + v[j].w); }
    if (NORM) {
        const float mean = wave_sum(s) * (1.f / DM); float s2 = 0.f;
#pragma unroll
        for (int j = 0; j < 4; ++j) { v[j] = v[j] - mean; s2 += (v[j].x * v[j].x + v[j].y * v[j].y) + (v[j].z * v[j].z + v[j].w * v[j].w); }
        const float rstd = 1.f / sqrtf(wave_sum(s2) * (1.f / DM) + LN_EPS);
#pragma unroll
        for (int j = 0; j < 4; ++j) { const f32x4 gg = ((const f32x4*)g)[lane + 64 * j], bb = ((const f32x4*)b)[lane + 64 * j]; v[j] = v[j] * rstd * gg + bb; }
    }
    f32x4* of = (f32x4*)dstf + lane; unsigned long long* ob = (unsigned long long*)dstb + lane;
#pragma unroll
    for (int j = 0; j < 4; ++j) { if (WF32) of[64 * j] = v[j]; if (WB16) ob[64 * j] = (unsigned long long)pk(v[j].x, v[j].y) | ((unsigned long long)pk(v[j].z, v[j].w) << 32); }
}
__device__ __forceinline__ void tokpos(int m, int& t, int& S) { if (m < MHALF) { S = 4096; t = m & 4095; } else { S = 8192; t = (m - MHALF) & 8191; } }
__device__ __forceinline__ void prep_row(bf16_t* z, bf16_t* mix, int m, int lane, const float2* rope, const float* qn, const float* kn, const float* cw, const float* cb) {
    int t, S; tokpos(m, t, S);
    bf16_t* zr = z + (size_t)m * INW;
    const int p = lane & 31, hh = lane >> 5;
    const float2 cs = rope[t * 32 + p];
    const float gq0 = qn[2 * p], gq1 = qn[2 * p + 1], gk0 = kn[2 * p], gk1 = kn[2 * p + 1];
    {
        const int head = 8 + hh; unsigned* wp = (unsigned*)(zr + head * 64 + 2 * p); const unsigned w = *wp;
        const float x0 = bf2f(w & 0xffffu), x1 = bf2f(w >> 16);
        float ss = x0 * x0 + x1 * x1;
        ss = half_sum(ss);
        const float r = 1.f / sqrtf(ss * (1.f / 64.f) + LN_EPS);
        const bool isq = head < 8;
        const float y0 = x0 * r * (isq ? gq0 : gk0), y1 = x1 * r * (isq ? gq1 : gk1);
        float o0 = y0 * cs.x - y1 * cs.y, o1 = y0 * cs.y + y1 * cs.x;
        if (isq) { o0 *= attn_body::C2; o1 *= attn_body::C2; }
        *wp = pk(o0, o1);
    }
}
__device__ __forceinline__ void conv_mix_unit(const bf16_t* Z, bf16_t* mix, const float* E2, const float* cw, const float* cbias, long row0, int h, int t0, int S, int tid) {
    const int pm = (int)(row0 >> 8);
#pragma unroll
    for (int it = 0; it < 4; ++it) {
        const int idx = tid + 512 * it, r = idx >> 3, ch = h * 64 + (idx & 7) * 8; const size_t row = (size_t)row0 + r;
        float fb[8], cp[8];
        unpack8(*(const u32x4*)(Z + row * INW + 768 + ch), fb);
        if (r == 0 || r == 255) {
            const float* Ep = E2 + (size_t)pm * 4 * 512 + ch; const bool last = r == 255;
            const float* r0 = last ? Ep + 2 * 512 : Ep - 512; const float* r1 = last ? Ep + 3 * 512 : Ep; const float* r2 = last ? Ep + 4 * 512 : Ep + 512;
            const bool hasp = t0 + r > 0, hasn = t0 + r < S - 1;
#pragma unroll
            for (int i = 0; i < 8; ++i) cp[i] = cw[ch + i] * (hasp ? r0[i] : 0.f) + cw[512 + ch + i] * r1[i] + cw[1024 + ch + i] * (hasn ? r2[i] : 0.f) + cbias[ch + i];
        } else unpack8(*(const u32x4*)(Z + row * INW + 1280 + ch), cp);
        u32x4 w; w.x = pk(fb[0] * cp[0], fb[1] * cp[1]); w.y = pk(fb[2] * cp[2], fb[3] * cp[3]); w.z = pk(fb[4] * cp[4], fb[5] * cp[5]); w.w = pk(fb[6] * cp[6], fb[7] * cp[7]);
        *(u32x4*)(mix + row * DM + 512 + ch) = w;
    }
}
__device__ __forceinline__ void row_stats_to_lds(const float* SP, int pm, LAS f2v* T, int tid) {
    if (tid < 256) { const f32x4* p = (const f32x4*)(SP + (size_t)(pm * 256 + tid) * 32); float s1 = 0.f, s2 = 0.f;
#pragma unroll
        for (int k = 0; k < 8; ++k) { const f32x4 v = p[k]; s1 += v.x + v.z; s2 += v.y + v.w; }
        const float mu = s1 * (1.f / DM), var = s2 * (1.f / DM) - mu * mu;
        T[tid] = (f2v){mu, 1.f / sqrtf(var + LN_EPS)}; }
    asm volatile("s_waitcnt lgkmcnt(0)" ::: "memory"); __builtin_amdgcn_s_barrier(); asm volatile("" ::: "memory");
}
#define DPPF(old, src, ctrl) __int_as_float(__builtin_amdgcn_update_dpp(__float_as_int(old), __float_as_int(src), (ctrl), 0xf, 0xf, false))
#define DPPZ(src, ctrl) __int_as_float(__builtin_amdgcn_update_dpp(0, __float_as_int(src), (ctrl), 0xf, 0xf, true))
__device__ __forceinline__ float silu_mul(float G, float V) { return G * __builtin_amdgcn_rcpf(1.f + __builtin_amdgcn_exp2f(-1.4426950408889634f * G)) * V; }
struct EpiFfn {
    static constexpr bool PERM = true, AFTER_DRAIN = false;
    bf16_t* H; float* E; const float* fw; const float* fb; LAS float* R; const float* SP; const float* cvec; const float* dvec; LAS f2v* T; mutable int last_pm;
    __device__ __forceinline__ void operator()(pg8::f32x4 (&acc)[2][2][4][2], const pg8::Unit& u, int wr, int wc, int fr, int fq) const {
        typedef pg8::f32x4 f4;
        const int cidx = (wc * 4 + fq) * 16, cl = 32 * wc + 8 * fq;
        if (u.pm != last_pm) { row_stats_to_lds(SP, u.pm, T, (wr * 4 + wc) * 64 + fq * 16 + fr); last_pm = u.pm; }
#pragma unroll
        for (int bj = 0; bj < 2; ++bj)
#pragma unroll
            for (int n = 0; n < 2; ++n) { const f4 cv = *(const f4*)(cvec + u.pn * 256 + 128 * bj + cl + 4 * n), dv = *(const f4*)(dvec + u.pn * 256 + 128 * bj + cl + 4 * n);
#pragma unroll
                for (int ai = 0; ai < 2; ++ai)
#pragma unroll
                    for (int m = 0; m < 4; ++m) { const f2v st = T[ai * 128 + wr * 64 + m * 16 + fr]; acc[ai][bj][m][n] = acc[ai][bj][m][n] * st.y + (cv * (-st.x * st.y) + dv); } }
#pragma unroll
        for (int ai = 0; ai < 2; ++ai) { const int s = 2 * ai + wr;
            if (fr == 0) {
#pragma unroll
                for (int bj = 0; bj < 2; ++bj)
#pragma unroll
                    for (int n = 0; n < 2; ++n) *(LAS f4*)(R + (2 * s) * 256 + cidx + (bj * 2 + n) * 4) = acc[ai][bj][0][n]; }
            if (fr == 15) {
#pragma unroll
                for (int bj = 0; bj < 2; ++bj)
#pragma unroll
                    for (int n = 0; n < 2; ++n) *(LAS f4*)(R + (2 * s + 1) * 256 + cidx + (bj * 2 + n) * 4) = acc[ai][bj][3][n]; } }
        { float* Eb = E + (size_t)u.pm * 4 * UPW + u.pn * 256 + cl;
            if (wr == 0 && fr < 2) {
#pragma unroll
                for (int bj = 0; bj < 2; ++bj)
#pragma unroll
                    for (int n = 0; n < 2; ++n) *(f4*)(Eb + fr * UPW + 128 * bj + 4 * n) = acc[0][bj][0][n]; }
            if (wr == 1 && fr >= 14) {
#pragma unroll
                for (int bj = 0; bj < 2; ++bj)
#pragma unroll
                    for (int n = 0; n < 2; ++n) *(f4*)(Eb + (fr - 12) * UPW + 128 * bj + 4 * n) = acc[1][bj][3][n]; } }
        asm volatile("s_waitcnt lgkmcnt(0)" ::: "memory"); __builtin_amdgcn_s_barrier(); asm volatile("" ::: "memory");
#pragma unroll
        for (int n = 0; n < 2; ++n) {
            const int chg = 128 * u.pn + cl + 4 * n;
            const f4 w0g = *(const f4*)(fw + chg), w1g = *(const f4*)(fw + UPW + chg), w2g = *(const f4*)(fw + 2 * UPW + chg), bg = *(const f4*)(fb + chg);
            const f4 w0v = *(const f4*)(fw + DFF + chg), w1v = *(const f4*)(fw + UPW + DFF + chg), w2v = *(const f4*)(fw + 2 * UPW + DFF + chg), bv = *(const f4*)(fb + DFF + chg);
#pragma unroll
            for (int ai = 0; ai < 2; ++ai) { const int s = 2 * ai + wr;
                const int ra = (s > 0 ? 2 * s - 1 : 0) * 256 + cidx + n * 4, rb = (s < 3 ? 2 * s + 2 : 7) * 256 + cidx + n * 4;
                const f4 abg = *(const LAS f4*)(R + ra), abv = *(const LAS f4*)(R + ra + 8), beg = *(const LAS f4*)(R + rb), bev = *(const LAS f4*)(R + rb + 8);
#pragma unroll
                for (int e = 0; e < 4; ++e) {
                    float opg = 0.f, opv = 0.f;
#pragma unroll
                    for (int m = 0; m < 4; ++m) {
                        const float cg_ = acc[ai][0][m][n][e], cv_ = acc[ai][1][m][n][e];
                        float tg, tv, ng, nv;
                        if (m == 0) { tg = abg[e]; tv = abv[e]; } else { tg = DPPZ(opg, 0x10F); tv = DPPZ(opv, 0x10F); }
                        if (m == 3) { ng = beg[e]; nv = bev[e]; } else { ng = DPPZ(acc[ai][0][m + 1][n][e], 0x11F); nv = DPPZ(acc[ai][1][m + 1][n][e], 0x11F); }
                        const float pg_ = DPPF(tg, cg_, 0x111), pv_ = DPPF(tv, cv_, 0x111);
                        const float xg_ = DPPF(ng, cg_, 0x101), xv_ = DPPF(nv, cv_, 0x101);
                        const float Gv = w0g[e] * pg_ + w1g[e] * cg_ + w2g[e] * xg_ + bg[e];
                        const float Vv = w0v[e] * pv_ + w1v[e] * cv_ + w2v[e] * xv_ + bv[e];
                        opg = cg_; opv = cv_;
                        acc[ai][0][m][n][e] = silu_mul(Gv, Vv);
                    }
                    __builtin_amdgcn_sched_barrier(0);
                }
            }
        }
#pragma unroll
        for (int ai = 0; ai < 2; ++ai)
#pragma unroll
            for (int m = 0; m < 4; ++m) { bf16_t* p = H + (size_t)(u.pm * pg8::BM + ai * pg8::HALF + wr * 64 + m * 16 + fr) * DFF + 128 * u.pn + cl;
                const f4 v0 = acc[ai][0][m][0], v1 = acc[ai][0][m][1];
                u32x4 w; w.x = pk(v0[0], v0[1]); w.y = pk(v0[2], v0[3]); w.z = pk(v1[0], v1[1]); w.w = pk(v1[2], v1[3]);
                *(u32x4*)p = w; }
    }
};
__device__ __forceinline__ void ffn_fix_item(const float* E, bf16_t* H, int pm, int which, int ch, const float* fw, const float* fb) {
    const int m = pm * 256 + (which ? 255 : 0); int t, S; tokpos(m, t, S);
    const int j = ch >> 4, i8 = (ch & 15) * 8, ucg = 256 * j + i8, cg_ = 128 * j + i8, cv_ = DFF + cg_;
    const float* Ep = E + (size_t)pm * 4 * UPW + ucg;
    const float* r0 = which ? Ep + 2 * UPW : Ep - UPW;
    const float* r1 = which ? Ep + 3 * UPW : Ep;
    const float* r2 = which ? Ep + 4 * UPW : Ep + UPW;
    const bool hasp = t > 0, hasn = t < S - 1;
    float o[8];
#pragma unroll
    for (int q = 0; q < 2; ++q) {
        const f32x4 z4 = {0.f, 0.f, 0.f, 0.f};
        const f32x4 gm = hasp ? *(const f32x4*)(r0 + 4 * q) : z4, vm = hasp ? *(const f32x4*)(r0 + 128 + 4 * q) : z4, gp = hasn ? *(const f32x4*)(r2 + 4 * q) : z4, vp = hasn ? *(const f32x4*)(r2 + 128 + 4 * q) : z4;
        const f32x4 g1 = *(const f32x4*)(r1 + 4 * q), v1 = *(const f32x4*)(r1 + 128 + 4 * q);
        const f32x4 G = *(const f32x4*)(fw + cg_ + 4 * q) * gm + *(const f32x4*)(fw + UPW + cg_ + 4 * q) * g1 + *(const f32x4*)(fw + 2 * UPW + cg_ + 4 * q) * gp + *(const f32x4*)(fb + cg_ + 4 * q);
        const f32x4 V = *(const f32x4*)(fw + cv_ + 4 * q) * vm + *(const f32x4*)(fw + UPW + cv_ + 4 * q) * v1 + *(const f32x4*)(fw + 2 * UPW + cv_ + 4 * q) * vp + *(const f32x4*)(fb + cv_ + 4 * q);
#pragma unroll
        for (int i = 0; i < 4; ++i) o[4 * q + i] = silu_mul(G[i], V[i]);
    }
    u32x4 w; w.x = pk(o[0], o[1]); w.y = pk(o[2], o[3]); w.z = pk(o[4], o[5]); w.w = pk(o[6], o[7]);
    *(u32x4*)(H + (size_t)m * DFF + cg_) = w;
}
struct EpiZ {
    static constexpr bool PERM = true, AFTER_DRAIN = false;
    bf16_t* O; const float* SP; const float* cvec; const float* dvec; LAS f2v* T; float* E2; const float* cw; const float* cbias; LAS float* R; const float* rope; const float* kn; mutable int last_pm;
    __device__ __forceinline__ void store_tile(const pg8::f32x4 (&acc)[2][2][4][2], const pg8::Unit& u, int wr, int wc, int fr, int fq) const {
        typedef pg8::f32x4 f4;
        asm volatile("" : "+v"(fr));
        const int cbs = u.pn * 256 + wc * 32 + 8 * fq;
#pragma unroll
        for (int ai = 0; ai < 2; ++ai)
#pragma unroll
            for (int m = 0; m < 4; ++m) { bf16_t* rowp = O + (size_t)(u.pm * 256 + ai * 128 + wr * 64 + m * 16 + fr) * INW + cbs;
#pragma unroll
                for (int bj = 0; bj < 2; ++bj) { const f4 v0 = acc[ai][bj][m][0], v1 = acc[ai][bj][m][1];
                    u32x4 w; w.x = pk(v0[0], v0[1]); w.y = pk(v0[2], v0[3]); w.z = pk(v1[0], v1[1]); w.w = pk(v1[2], v1[3]);
                    *(u32x4*)(rowp + bj * 128) = w; } }
    }
    __device__ __forceinline__ void conv_tile(pg8::f32x4 (&acc)[2][2][4][2], const pg8::Unit& u, int wr, int wc, int fr, int fq) const {
        typedef pg8::f32x4 f4;
        const int cidx = (wc * 4 + fq) * 8, cl = 32 * wc + 8 * fq, jt = u.pn - 5;
#pragma unroll
        for (int ai = 0; ai < 2; ++ai)
#pragma unroll
            for (int m = 0; m < 4; ++m)
#pragma unroll
                for (int n = 0; n < 2; ++n) acc[ai][0][m][n] = acc[ai][0][m][n] * acc[ai][1][m][n];
#pragma unroll
        for (int ai = 0; ai < 2; ++ai) { const int s = 2 * ai + wr;
            if (fr == 0) {
#pragma unroll
                for (int n = 0; n < 2; ++n) *(LAS f4*)(R + (2 * s) * 128 + cidx + n * 4) = acc[ai][0][0][n]; }
            if (fr == 15) {
#pragma unroll
                for (int n = 0; n < 2; ++n) *(LAS f4*)(R + (2 * s + 1) * 128 + cidx + n * 4) = acc[ai][0][3][n]; } }
        { float* Eb = E2 + (size_t)u.pm * 4 * 512 + jt * 128 + cl;
            if (wr == 0 && fr < 2) {
#pragma unroll
                for (int n = 0; n < 2; ++n) *(f4*)(Eb + fr * 512 + 4 * n) = acc[0][0][0][n]; }
            if (wr == 1 && fr >= 14) {
#pragma unroll
                for (int n = 0; n < 2; ++n) *(f4*)(Eb + (fr - 12) * 512 + 4 * n) = acc[1][0][3][n]; } }
        asm volatile("s_waitcnt lgkmcnt(0)" ::: "memory"); __builtin_amdgcn_s_barrier(); asm volatile("" ::: "memory");
#pragma unroll
        for (int n = 0; n < 2; ++n) {
            const int ch = 128 * jt + cl + 4 * n;
            const f4 w0 = *(const f4*)(cw + ch), w1 = *(const f4*)(cw + 512 + ch), w2 = *(const f4*)(cw + 1024 + ch), bb = *(const f4*)(cbias + ch);
#pragma unroll
            for (int ai = 0; ai < 2; ++ai) { const int s = 2 * ai + wr;
                const int ra = (s > 0 ? 2 * s - 1 : 0) * 128 + cidx + n * 4, rb = (s < 3 ? 2 * s + 2 : 7) * 128 + cidx + n * 4;
                const f4 ab = *(const LAS f4*)(R + ra), be = *(const LAS f4*)(R + rb);
#pragma unroll
                for (int e = 0; e < 4; ++e) {
#pragma unroll
                    for (int m = 0; m < 4; ++m) {
                        const float c_ = acc[ai][0][m][n][e];
                        const float tp = (m == 0) ? ab[e] : DPPZ(acc[ai][0][m - 1][n][e], 0x10F);
                        const float tn = (m == 3) ? be[e] : DPPZ(acc[ai][0][m + 1][n][e], 0x11F);
                        const float pv_ = DPPF(tp, c_, 0x111), nx_ = DPPF(tn, c_, 0x101);
                        acc[ai][1][m][n][e] = w0[e] * pv_ + w1[e] * c_ + w2[e] * nx_ + bb[e];
                    }
                    __builtin_amdgcn_sched_barrier(0);
                }
            }
        }
#pragma unroll
        for (int ai = 0; ai < 2; ++ai)
#pragma unroll
            for (int m = 0; m < 4; ++m) { bf16_t* p = O + (size_t)(u.pm * 256 + ai * 128 + wr * 64 + m * 16 + fr) * INW + 1280 + 128 * jt + cl;
                const f4 v0 = acc[ai][1][m][0], v1 = acc[ai][1][m][1];
                u32x4 w; w.x = pk(v0[0], v0[1]); w.y = pk(v0[2], v0[3]); w.z = pk(v1[0], v1[1]); w.w = pk(v1[2], v1[3]);
                *(u32x4*)p = w; }
    }
    __device__ __forceinline__ void operator()(pg8::f32x4 (&acc)[2][2][4][2], const pg8::Unit& u, int wr, int wc, int fr, int fq) const {
        typedef pg8::f32x4 f4;
        if (u.pm != last_pm) { row_stats_to_lds(SP, u.pm, T, (wr * 4 + wc) * 64 + fq * 16 + fr); last_pm = u.pm; }
        const int cb = u.pn * 256 + wc * 32 + 8 * fq;
        f4 cv[2][2], dv[2][2];
#pragma unroll
        for (int bj = 0; bj < 2; ++bj)
#pragma unroll
            for (int n = 0; n < 2; ++n) { cv[bj][n] = *(const f4*)(cvec + cb + 128 * bj + 4 * n); dv[bj][n] = *(const f4*)(dvec + cb + 128 * bj + 4 * n); }
#pragma unroll
        for (int ai = 0; ai < 2; ++ai)
#pragma unroll
            for (int m = 0; m < 4; ++m) { const int rl = ai * 128 + wr * 64 + m * 16 + fr; const f2v st = T[rl]; const float r = st.y, rm = -st.x * st.y;
#pragma unroll
                for (int bj = 0; bj < 2; ++bj) { acc[ai][bj][m][0] = acc[ai][bj][m][0] * r + (cv[bj][0] * rm + dv[bj][0]); acc[ai][bj][m][1] = acc[ai][bj][m][1] * r + (cv[bj][1] * rm + dv[bj][1]); } }
        if (u.pn >= 5) { conv_tile(acc, u, wr, wc, fr, fq); return; }
        if (u.pn == 2) {
            float part[2][4];
            asm volatile("" : "+v"(fr), "+v"(fq));
#pragma unroll
            for (int ai = 0; ai < 2; ++ai)
#pragma unroll
                for (int m = 0; m < 4; ++m) { const f4 a0 = acc[ai][0][m][0], a1 = acc[ai][0][m][1];
                    float ss = ((a0[0] * a0[0] + a0[1] * a0[1]) + (a0[2] * a0[2] + a0[3] * a0[3])) + ((a1[0] * a1[0] + a1[1] * a1[1]) + (a1[2] * a1[2] + a1[3] * a1[3]));
                    ss += swz_xor<16>(ss); { auto rr = __builtin_amdgcn_permlane32_swap(__float_as_uint(ss), __float_as_uint(ss), false, false); ss = __uint_as_float(rr[0]) + __uint_as_float(rr[1]); }
                    part[ai][m] = ss; if (fq == 0) R[(ai * 128 + wr * 64 + m * 16 + fr) * 4 + wc] = ss; }
            asm volatile("s_waitcnt lgkmcnt(0)" ::: "memory"); __builtin_amdgcn_s_barrier(); asm volatile("" ::: "memory");
            const int dim0 = (wc & 1) * 32 + 8 * fq;
            const f4 g0 = *(const f4*)(kn + dim0), g1 = *(const f4*)(kn + dim0 + 4);
#pragma unroll
            for (int ai = 0; ai < 2; ++ai)
#pragma unroll
                for (int m = 0; m < 4; ++m) { const int rl = ai * 128 + wr * 64 + m * 16 + fr;
                    const float tot = part[ai][m] + R[rl * 4 + (wc ^ 1)], rn = 1.f / sqrtf(tot * (1.f / 64.f) + LN_EPS);
                    int t, S; tokpos(u.pm * 256 + rl, t, S);
                    const float* rp = rope + ((size_t)t * 32 + (dim0 >> 1)) * 2;
                    const f4 c01 = *(const f4*)rp, c23 = *(const f4*)(rp + 4);
                    const f4 a0 = acc[ai][0][m][0] * rn * g0, a1 = acc[ai][0][m][1] * rn * g1;
                    acc[ai][0][m][0] = (f4){a0[0] * c01[0] - a0[1] * c01[1], a0[0] * c01[1] + a0[1] * c01[0], a0[2] * c01[2] - a0[3] * c01[3], a0[2] * c01[3] + a0[3] * c01[2]};
                    acc[ai][0][m][1] = (f4){a1[0] * c23[0] - a1[1] * c23[1], a1[0] * c23[1] + a1[1] * c23[0], a1[2] * c23[2] - a1[3] * c23[3], a1[2] * c23[3] + a1[3] * c23[2]};
                    asm volatile("" ::: "memory"); __builtin_amdgcn_sched_barrier(0); }
            store_tile(acc, u, wr, wc, fr, fq); return;
        }
        store_tile(acc, u, wr, wc, fr, fq);
    }
};
struct EpiResLn {
    static constexpr bool PERM = true, AFTER_DRAIN = false;
    float* X; bf16_t* XB; const float* SPin; float* SPout; const float* g; const float* b; LAS f2v* T; float alpha;
    __device__ __forceinline__ void operator()(pg8::f32x4 (&acc)[2][2][4][2], const pg8::Unit& u, int wr, int wc, int fr, int fq) const {
        typedef pg8::f32x4 f4;
        row_stats_to_lds(SPin, u.pm, T, (wr * 4 + wc) * 64 + fq * 16 + fr);
        const int cb = u.pn * 256 + wc * 32 + 8 * fq;
        f4 gv[2][2], bv[2][2];
#pragma unroll
        for (int bj = 0; bj < 2; ++bj)
#pragma unroll
            for (int n = 0; n < 2; ++n) { gv[bj][n] = *(const f4*)(g + cb + 128 * bj + 4 * n); bv[bj][n] = *(const f4*)(b + cb + 128 * bj + 4 * n); }
#pragma unroll
        for (int ai = 0; ai < 2; ++ai)
#pragma unroll
            for (int m = 0; m < 4; ++m) { const int rl = ai * 128 + wr * 64 + m * 16 + fr; const f2v st = T[rl]; const float r = st.y, rm = -st.x * st.y;
                const size_t off = (size_t)(u.pm * 256 + rl) * DM + cb; float s1 = 0.f, s2 = 0.f;
#pragma unroll
                for (int bj = 0; bj < 2; ++bj) { f4 pre[2]; float xin[8]; unpack8(*(const u32x4*)(XB + off + 128 * bj), xin);
#pragma unroll
                    for (int n = 0; n < 2; ++n) { const f4 v = {xin[4 * n], xin[4 * n + 1], xin[4 * n + 2], xin[4 * n + 3]}; const f4 xr = (v * r + rm) * gv[bj][n] + bv[bj][n];
                        pre[n] = xr * alpha + acc[ai][bj][m][n]; if (X) *(f4*)(X + off + 128 * bj + 4 * n) = pre[n];
                        s1 += (pre[n][0] + pre[n][1]) + (pre[n][2] + pre[n][3]); s2 += (pre[n][0] * pre[n][0] + pre[n][1] * pre[n][1]) + (pre[n][2] * pre[n][2] + pre[n][3] * pre[n][3]); }
                    u32x4 w; w.x = pk(pre[0][0], pre[0][1]); w.y = pk(pre[0][2], pre[0][3]); w.z = pk(pre[1][0], pre[1][1]); w.w = pk(pre[1][2], pre[1][3]);
                    if (!X) *(u32x4*)(XB + off + 128 * bj) = w; }
                s1 += swz_xor<16>(s1); s2 += swz_xor<16>(s2);
                { auto r1 = __builtin_amdgcn_permlane32_swap(__float_as_uint(s1), __float_as_uint(s1), false, false); s1 = __uint_as_float(r1[0]) + __uint_as_float(r1[1]);
                  auto r2 = __builtin_amdgcn_permlane32_swap(__float_as_uint(s2), __float_as_uint(s2), false, false); s2 = __uint_as_float(r2[0]) + __uint_as_float(r2[1]); }
                if (fq == 0) *(f2v*)(SPout + (size_t)(u.pm * 256 + rl) * 32 + (u.pn * 4 + wc) * 2) = (f2v){s1, s2};
            }
    }
};

#define XB_TMO      128
#define XB_XCNT(j)  (256  + 64 * (j))
#define XB_XSUB(j)  (1280 + 64 * (j))
#define XB_XGEN(j)  (2304 + 64 * (j))
#define XB_TOP      3328
#define XB_TOPGEN   3392
#define XCD_BAR_WORDS 3456
#define XB_SPIN_CAP (1u << 18)

__device__ __forceinline__ unsigned xb_ld(unsigned* p)              { return __hip_atomic_load(p, __ATOMIC_RELAXED, __HIP_MEMORY_SCOPE_AGENT); }
__device__ __forceinline__ unsigned xb_add(unsigned* p, unsigned v) { return __hip_atomic_fetch_add(p, v, __ATOMIC_RELAXED, __HIP_MEMORY_SCOPE_AGENT); }
__device__ __forceinline__ unsigned xb_xcc_id() { return (unsigned)__builtin_amdgcn_s_getreg((3 << 11) | 20) & 0xFu; }
#define XB_SPIN(cond, bar) do { unsigned _sp = 0; while (cond) { __builtin_amdgcn_s_sleep(1); \
    if ((++_sp & 255u) == 0u) { if (xb_ld(&(bar)[XB_TMO])) break; if (_sp > XB_SPIN_CAP) { atomicAdd(&(bar)[XB_TMO], 1u); break; } } } } while (0)

struct XcdBarrier {
    unsigned* bar; unsigned x;
    volatile LAS unsigned* st;
};

__device__ __forceinline__ XcdBarrier xcd_barrier_post(unsigned* bar, volatile LAS unsigned* st) {
    XcdBarrier b; b.bar = bar; b.x = xb_xcc_id(); b.st = st;
    if (threadIdx.x == 0) (void)xb_add(&bar[XB_XCNT(b.x)], 1u);
    return b;
}
__device__ __forceinline__ void xcd_barrier_complete(unsigned* bar, unsigned x, unsigned& nloc, unsigned& nx) {
    const unsigned G = gridDim.x * gridDim.y * gridDim.z;
    unsigned sum, cnt, mine, sp = 0u;
    for (;;) {
        sum = 0u; cnt = 0u; mine = 0u;
#pragma unroll
        for (unsigned j = 0; j < 16; ++j) { const unsigned c = xb_ld(&bar[XB_XCNT(j)]); sum += c; cnt += (c > 0u) ? 1u : 0u; mine = (j == x) ? c : mine; }
        if (sum == G) break;
        __builtin_amdgcn_s_sleep(1);
        if ((++sp & 255u) == 0u) { if (xb_ld(&bar[XB_TMO])) break; if (sp > XB_SPIN_CAP) { atomicAdd(&bar[XB_TMO], 1u); break; } }
    }
    nloc = mine > 0u ? mine : 1u; nx = cnt > 0u ? cnt : 1u;
}

__device__ __forceinline__ void xcd_barrier(const XcdBarrier& b) {
    asm volatile("s_waitcnt vmcnt(0)" ::: "memory");
    __syncthreads();
    if (threadIdx.x == 0) {
        unsigned* bar = b.bar;
        __builtin_amdgcn_s_waitcnt(0);
        unsigned nloc = b.st[0], nx = b.st[1];
        if (nloc == 0u) { xcd_barrier_complete(bar, b.x, nloc, nx); b.st[0] = nloc; b.st[1] = nx; }
        const unsigned old = xb_add(&bar[XB_XSUB(b.x)], 1u);
        const unsigned gen = old / nloc;
        if (old + 1u == (gen + 1u) * nloc) {
            __builtin_amdgcn_fence(__ATOMIC_RELEASE, "agent");
            asm volatile("s_waitcnt vmcnt(0)" ::: "memory");
            const unsigned og = xb_add(&bar[XB_TOP], 1u);
            const unsigned tg = og / nx;
            if (og + 1u == (tg + 1u) * nx) xb_add(&bar[XB_TOPGEN], 1u);
            else XB_SPIN(xb_ld(&bar[XB_TOPGEN]) == tg, bar);
            __builtin_amdgcn_fence(__ATOMIC_ACQUIRE, "agent");
            xb_add(&bar[XB_XGEN(b.x)], 1u);
            asm volatile("s_waitcnt vmcnt(0)" ::: "memory");
        } else {
            XB_SPIN(xb_ld(&bar[XB_XGEN(b.x)]) == gen, bar);
            __builtin_amdgcn_fence(__ATOMIC_ACQUIRE, "agent");
            asm volatile("s_waitcnt vmcnt(0)" ::: "memory");
        }
    }
    __syncthreads();
}

struct Args { const float* in[16]; float* out; unsigned char* ws; };

#define ENV() \
    const __attribute__((address_space(4))) Args* ap = kp; asm volatile("" : "+s"(ap)); \
    int tid = threadIdx.x; asm volatile("" : "+v"(tid)); \
    const int lane = tid & 63, wave = __builtin_amdgcn_readfirstlane(tid >> 6); \
    const int G = gridDim.x, bx = blockIdx.x; \
    const int vcu = (G % 8 == 0) ? (bx % 8) * (G / 8) + bx / 8 : bx; \
    const int gw = vcu * 8 + wave, NGW = G * 8; \
    const size_t gtid = (size_t)bx * 512 + tid, gsz = (size_t)G * 512; \
    unsigned char* ws = ap->ws; float* X = ap->out; \
    bf16_t* XBF = (bf16_t*)(ws + WS_XBF); bf16_t* Z = (bf16_t*)(ws + WS_Z); bf16_t* MIX = (bf16_t*)(ws + WS_MIX); \
    bf16_t* H = (bf16_t*)(ws + WS_H); float* EDGE = (float*)(ws + WS_EDGE); float2* ROPE = (float2*)(ws + WS_ROPE); \
    float* SPA = (float*)(ws + WS_SPA); float* SPB = (float*)(ws + WS_SPB); float* CDIN = (float*)(ws + WS_CDIN); float* CDUP = (float*)(ws + WS_CDUP); \
    float2* PIN = (float2*)(ws + WS_PIN); float2* PUP = (float2*)(ws + WS_PUP); float* ONES = (float*)(ws + WS_ONES); float* EDGE2 = (float*)(ws + WS_EDGE2); (void)EDGE2; LAS f2v* TST = (LAS f2v*)((LAS unsigned char*)lds + ST_OFF); \
    (void)SPA; (void)SPB; (void)CDIN; (void)CDUP; (void)PIN; (void)PUP; (void)ONES; (void)TST; \
    (void)lane; (void)wave; (void)gw; (void)NGW; (void)gtid; (void)gsz; (void)X; (void)XBF; (void)Z; (void)MIX; (void)EDGE; (void)H; (void)ROPE;

__global__ void __launch_bounds__(512, 2) mega_fwd(Args a_unused) {
    extern __shared__ __attribute__((aligned(16))) unsigned char lds[];
    cg::grid_group grid = cg::this_grid();
    const __attribute__((address_space(4))) Args* kp = (const __attribute__((address_space(4))) Args*)__builtin_amdgcn_kernarg_segment_ptr();

    if (threadIdx.x < 2) ((volatile LAS unsigned*)((LAS unsigned char*)lds + BARST_OFF))[threadIdx.x] = 0u;
    __syncthreads();
    {
        ENV();
        if (bx == 0) for (int i = tid; i < XCD_BAR_WORDS; i += 512) ((unsigned*)(ws + WS_BAR))[i] = 0u;
        LAS float* scr = (LAS float*)((LAS unsigned char*)lds + wave * 16384);
        constexpr int I_IN = 16 * 72, I_O = 16 * 32, I_UP = 16 * 176, I_DN = 44 * 32, I_L = I_IN + I_O + I_UP + I_DN;
        for (int it = gw; it < NLAYER * I_L; it += NGW) {
            const int l = it / I_L; int r = it % I_L; unsigned char* wl = ws + WS_W + (size_t)l * W_LAYER;
            if (r < I_IN) { const bool f = l > 0;
                transpose_item(ap->in[2] + (size_t)l * DM * INW, DM, INW, (bf16_t*)(wl + W_IN), 1280, 512, f ? ap->in[14] + (l - 1) * DM : nullptr, f ? ap->in[15] + (l - 1) * DM : nullptr,
                               f ? PIN + (size_t)l * 16 * INW : nullptr, scr, r, lane); continue; } r -= I_IN;
            if (r < I_O) { transpose_item(ap->in[7] + (size_t)l * DM * DM, DM, DM, (bf16_t*)(wl + W_O), 0, 0, nullptr, nullptr, nullptr, scr, r, lane); continue; } r -= I_O;
            if (r < I_UP) { transpose_item(ap->in[10] + (size_t)l * DM * UPW, DM, UPW, (bf16_t*)(wl + W_UP), 0, DFF, ap->in[8] + l * DM, ap->in[9] + l * DM, PUP + (size_t)l * 16 * UPW, scr, r, lane); continue; } r -= I_UP;
            transpose_item(ap->in[13] + (size_t)l * DFF * DM, DFF, DM, (bf16_t*)(wl + W_DOWN), 0, 0, nullptr, nullptr, nullptr, scr, r, lane);
        }
        for (size_t i = gtid; i < (size_t)MTOK * 8; i += gsz) ((f32x4*)SPB)[i] = (i & 7) == 0 ? (f32x4){0.f, (float)DM * (1.f - LN_EPS), 0.f, 0.f} : (f32x4){0.f, 0.f, 0.f, 0.f};
        for (size_t i = gtid; i < 2048; i += gsz) ONES[i] = i < 1024 ? 1.f : 0.f;
        for (size_t i = gtid; i < 2 * INW; i += gsz) CDIN[i] = 0.f;
        for (size_t i = gtid; i < 8192 * 32; i += gsz) {
            const int t = (int)(i >> 5), p = (int)(i & 31); const int pos = p < 16 ? (t >> 6) : (t & 63);
            const float angf = (float)pos * __builtin_amdgcn_exp2f(-(float)(p & 15) * 0.83048202372184059f);
            double r = (double)angf; r -= 6.283185307179586476925 * __builtin_rint(r * 0.15915494309189533577);
            const double r2 = r * r; double sn, cs;
            sn = -1.0 / 51090942171709440000.0; cs = 1.0 / 2432902008176640000.0;
            sn = sn * r2 + 1.0 / 121645100408832000.0; cs = cs * r2 - 1.0 / 6402373705728000.0;
            sn = sn * r2 - 1.0 / 355687428096000.0;    cs = cs * r2 + 1.0 / 20922789888000.0;
            sn = sn * r2 + 1.0 / 1307674368000.0;      cs = cs * r2 - 1.0 / 87178291200.0;
            sn = sn * r2 - 1.0 / 6227020800.0;         cs = cs * r2 + 1.0 / 479001600.0;
            sn = sn * r2 + 1.0 / 39916800.0;           cs = cs * r2 - 1.0 / 3628800.0;
            sn = sn * r2 - 1.0 / 362880.0;             cs = cs * r2 + 1.0 / 40320.0;
            sn = sn * r2 + 1.0 / 5040.0;               cs = cs * r2 - 1.0 / 720.0;
            sn = sn * r2 - 1.0 / 120.0;                cs = cs * r2 + 1.0 / 24.0;
            sn = sn * r2 + 1.0 / 6.0;                  cs = cs * r2 - 1.0 / 2.0;
            sn = sn * r2 - 1.0; sn = -sn * r;          cs = cs * r2 + 1.0;
            ROPE[i] = make_float2((float)cs, (float)sn);
        }
        for (int m = gw; m < MTOK; m += NGW) {
            const float* src = m < MHALF ? ap->in[0] + (size_t)m * DM : ap->in[1] + (size_t)(m - MHALF) * DM;
            row_pass<false, false>(src, nullptr, XBF + (size_t)m * DM, nullptr, nullptr, lane);
        }
    }
    grid.sync();
    const XcdBarrier xbar = xcd_barrier_post((unsigned*)(kp->ws + WS_BAR), (volatile LAS unsigned*)((LAS unsigned char*)lds + BARST_OFF));

#pragma nounroll
    for (int l = 0; l < NLAYER; ++l) {
        {
            ENV(); unsigned char* wl = ws + WS_W + (size_t)l * W_LAYER;
            pg8::Gemm g{XBF, (const bf16_t*)(wl + W_IN), MTOK, INW, DM}; pg8::StaticOrder S; S.init(MTOK, INW, G, bx);
            EpiZ E{Z, SPB, CDIN + (size_t)l * 2 * INW, CDIN + (size_t)l * 2 * INW + INW, TST, EDGE2, ap->in[5] + l * 3 * 512, ap->in[6] + l * 512, (LAS float*)((LAS unsigned char*)lds + HALO_OFF), (const float*)ROPE, ap->in[4] + l * 64, -1};
            pg8::gemm_phase<EpiZ, pg8::StaticOrder, true, true>((LAS unsigned char*)lds, g, S, E);
        }
        xcd_barrier(xbar);
        {
            ENV();
            if (l == 0) {
                for (size_t i = gtid; i < (size_t)3 * INW + 4 * UPW; i += gsz) {
                    const bool up = i >= (size_t)3 * INW; const int N = up ? UPW : INW; const int r = up ? (int)(i - 3 * INW) : (int)i + INW, ll = r / N, n = r % N;
                    const float2* P = (up ? PUP : PIN) + (size_t)ll * 16 * N + n; float cs = 0.f, ds = 0.f;
#pragma unroll
                    for (int kb = 0; kb < 16; ++kb) { const float2 v = P[(size_t)kb * N]; cs += v.x; ds += v.y; }
                    float* CD = (up ? CDUP : CDIN) + (size_t)ll * 2 * N; CD[n] = cs; CD[N + n] = ds;
                }
            }
            const int xcd = vcu >> 5, jc = vcu & 31;
#pragma nounroll
            for (int i = 0; i < 8; ++i) {
                long rowbase; int NT, qb, h, kvh;
                if (i < 4) { const int ui = jc * 4 + i; kvh = xcd & 1; h = kvh * 4 + (ui >> 5); qb = ui & 31; rowbase = MHALF + (long)(xcd >> 1) * 8192; NT = 128; }
                else { const int ui = jc * 4 + (i - 4), pair = 2 * xcd + (ui >> 6), r = ui & 63; kvh = pair & 1; h = kvh * 4 + (r >> 4); qb = r & 15; rowbase = (long)(pair >> 1) * 4096; NT = 64; }
                attn_body::attn_unit<8>(rowbase, NT, qb * 256, (const attn_body::bf16*)(Z + h * 64), (const attn_body::bf16*)(Z + 512 + kvh * 64), (const attn_body::bf16*)(Z + 640 + kvh * 64),
                                        (attn_body::bf16*)(MIX + h * 64), (char*)lds, (const float*)ROPE, ap->in[3] + l * 64);
                conv_mix_unit(Z, MIX, EDGE2, ap->in[5] + l * 3 * 512, ap->in[6] + l * 512, rowbase + qb * 256, h, qb * 256, NT * 64, tid);
            }
        }
        xcd_barrier(xbar);
        {
            ENV(); unsigned char* wl = ws + WS_W + (size_t)l * W_LAYER;
            pg8::Gemm g{MIX, (const bf16_t*)(wl + W_O), MTOK, DM, DM}; pg8::StaticOrder S; S.init(MTOK, DM, G, bx);
            EpiResLn E{nullptr, XBF, SPB, SPA, l > 0 ? ap->in[14] + (l - 1) * DM : ONES, l > 0 ? ap->in[15] + (l - 1) * DM : ONES + 1024, TST, ALPHA};
            pg8::gemm_phase<EpiResLn, pg8::StaticOrder, true, true>((LAS unsigned char*)lds, g, S, E);
        }
        xcd_barrier(xbar);
        {
            ENV(); unsigned char* wl = ws + WS_W + (size_t)l * W_LAYER;
            pg8::Gemm g{XBF, (const bf16_t*)(wl + W_UP), MTOK, UPW, DM}; pg8::StaticOrder S; S.init(MTOK, UPW, G, bx);
            EpiFfn E{H, EDGE, ap->in[11] + (size_t)l * 3 * UPW, ap->in[12] + (size_t)l * UPW, (LAS float*)((LAS unsigned char*)lds + HALO_OFF), SPA, CDUP + (size_t)l * 2 * UPW, CDUP + (size_t)l * 2 * UPW + UPW, TST, -1};
            pg8::gemm_phase<EpiFfn, pg8::StaticOrder, true, true>((LAS unsigned char*)lds, g, S, E);
        }
        xcd_barrier(xbar);
        {
            ENV();
            const float* fw = ap->in[11] + (size_t)l * 3 * UPW; const float* fb = ap->in[12] + (size_t)l * UPW;
            for (size_t it = gtid; it < (size_t)512 * 352; it += gsz) { const int rr = (int)(it / 352), ch = (int)(it % 352); ffn_fix_item(EDGE, H, rr >> 1, rr & 1, ch, fw, fb); }
        }
        xcd_barrier(xbar);
        {
            ENV(); unsigned char* wl = ws + WS_W + (size_t)l * W_LAYER;
            pg8::Gemm g{H, (const bf16_t*)(wl + W_DOWN), MTOK, DM, DFF}; pg8::StaticOrder S; S.init(MTOK, DM, G, bx);
            EpiResLn E{l == NLAYER - 1 ? X : nullptr, XBF, SPA, SPB, ap->in[8] + l * DM, ap->in[9] + l * DM, TST, ALPHA};
            pg8::gemm_phase<EpiResLn, pg8::StaticOrder, true, true>((LAS unsigned char*)lds, g, S, E);
        }
        xcd_barrier(xbar);
    }
    {
        ENV();
        for (int m = gw; m < MTOK; m += NGW) row_pass<true, true, false>(X + (size_t)m * DM, X + (size_t)m * DM, nullptr, ap->in[14] + (NLAYER - 1) * DM, ap->in[15] + (NLAYER - 1) * DM, lane);
    }
}
}

extern "C" void kernel_launch(void* const* d_in, const int* in_sizes, int n_in, void* d_out, int out_size, void* d_ws, size_t ws_size, hipStream_t stream) {
    static int grid = 0;
    if (grid == 0) {
        if (n_in != 16 || out_size != mk::MTOK * mk::DM || ws_size < mk::WS_END) { fprintf(stderr, "kernel_launch: unexpected shapes (n_in %d out %d ws %zu)\n", n_in, out_size, ws_size); grid = -1; return; }
        int dev = 0, cus = 0, per_cu = 0;
        (void)hipGetDevice(&dev);
        (void)hipDeviceGetAttribute(&cus, hipDeviceAttributeMultiprocessorCount, dev);
        (void)hipFuncSetAttribute((const void*)mk::mega_fwd, hipFuncAttributeMaxDynamicSharedMemorySize, mk::LDS_BYTES);
        (void)hipOccupancyMaxActiveBlocksPerMultiprocessor(&per_cu, (const void*)mk::mega_fwd, 512, mk::LDS_BYTES);
        (void)hipGetLastError();
        grid = cus;
        fprintf(stderr, "kernel_launch: cus %d per_cu %d grid %d\n", cus, per_cu, grid);
    }
    if (grid < 0) return;
    mk::Args a{};
    for (int i = 0; i < 16; ++i) a.in[i] = (const float*)d_in[i];
    a.out = (float*)d_out; a.ws = (unsigned char*)d_ws;
    void* args[] = {&a};
    hipError_t e = hipLaunchCooperativeKernel((const void*)mk::mega_fwd, dim3(grid), dim3(512), args, mk::LDS_BYTES, stream);
    if (e != hipSuccess) fprintf(stderr, "cooperative launch failed: %s (grid %d)\n", hipGetErrorString(e), grid);
}
```
